# Optimizing an MI355X kernel written in HIP

```python
import math
import jax, jax.numpy as jnp
from jax import lax
import numpy as np

D_MODEL = 1024
BATCH = 16
SEQ = 2048
DEPTH = 2

NORM_EPS = 1e-6
ROPE_THETA = 500000.0
HEAD_DIM = 64
ROT_DIM = HEAD_DIM // 4
NEG_INF = -1e30
Q_BLOCK = 128
RNN_WIDTH = D_MODEL // 2
RNN_BLOCKS = 8
RNN_BLOCK = RNN_WIDTH // RNN_BLOCKS
CONV_WIDTH = 4
RGLRU_C = 8.0
DIFF_HEADS = (D_MODEL // 2) // (2 * HEAD_DIM)
DIFF_QK_WIDTH = DIFF_HEADS * 2 * HEAD_DIM
DIFF_V_DIM = 2 * HEAD_DIM
DIFF_WIDTH = DIFF_HEADS * DIFF_V_DIM
AB_IN_WIDTH = 2 * RNN_WIDTH + 2 * DIFF_QK_WIDTH + DIFF_WIDTH
DIL_HEADS = D_MODEL // HEAD_DIM
DIL_PATTERNS = ((128, 1), (512, 4), (2048, 16))
D_FF = -(-8 * D_MODEL // (3 * 256)) * 256
N_EVEN = (DEPTH + 1) // 2
N_ODD = DEPTH // 2

kernel_name = "hawk_diffattn_dilated_hybrid"


def rms_norm(x, g):
    xf = x.astype(jnp.float32)
    y = xf * lax.rsqrt(jnp.mean(xf * xf, axis=-1, keepdims=True) + NORM_EPS)
    return (y * g.astype(jnp.float32)).astype(x.dtype)


def rope_tables(seq_len):
    pos = jnp.arange(seq_len, dtype=jnp.float32)
    inv_freq = 1.0 / (ROPE_THETA ** (jnp.arange(0, ROT_DIM, 2, dtype=jnp.float32) / ROT_DIM))
    ang = pos[:, None] * inv_freq[None, :]
    return jnp.cos(ang), jnp.sin(ang)


def apply_partial_rope(t, cos, sin):
    shape = (cos.shape[0],) + (1,) * (t.ndim - 3) + (cos.shape[1],)
    c = cos.reshape(shape)
    s = sin.reshape(shape)
    tf = t.astype(jnp.float32)
    half = ROT_DIM // 2
    x1 = tf[..., :half]
    x2 = tf[..., half:ROT_DIM]
    out = jnp.concatenate([x1 * c - x2 * s, x2 * c + x1 * s, tf[..., ROT_DIM:]], axis=-1)
    return out.astype(t.dtype)


def rglru_block(xr, gate, conv_w, conv_b, wa, ba, wx, bx, lru_lambda):
    B, S, W = xr.shape
    xp = jnp.pad(xr, ((0, 0), (CONV_WIDTH - 1, 0), (0, 0)))
    u = conv_b + sum(xp[:, j:j + S, :] * conv_w[j] for j in range(CONV_WIDTH))
    ub = u.reshape(B, S, RNN_BLOCKS, RNN_BLOCK)
    r = jax.nn.sigmoid((jnp.einsum('bsgi,gij->bsgj', ub, wa).reshape(B, S, W) + ba).astype(jnp.float32))
    i = jax.nn.sigmoid((jnp.einsum('bsgi,gij->bsgj', ub, wx).reshape(B, S, W) + bx).astype(jnp.float32))
    log_a = -RGLRU_C * r * jax.nn.softplus(-lru_lambda.astype(jnp.float32))
    a = jnp.exp(log_a)
    b = jnp.sqrt(-jnp.expm1(2.0 * log_a)) * (i * u.astype(jnp.float32))

    def combine(left, right):
        a1, b1 = left
        a2, b2 = right
        return a1 * a2, a2 * b1 + b2

    _, h = lax.associative_scan(combine, (a, b), axis=1)
    return (h * jax.nn.gelu(gate.astype(jnp.float32))).astype(xr.dtype)


def diff_attention(q, k, v, lam, lambda_init, subln_g):
    B, S, H, _, Dh = q.shape
    nb = S // Q_BLOCK
    qb = q.reshape(B, nb, Q_BLOCK, H, 2, Dh).transpose(1, 0, 2, 3, 4, 5)
    kf = k.astype(jnp.float32)
    vf = v.astype(jnp.float32)
    k_pos = jnp.arange(S)

    def one_block(args):
        qblk, bi = args
        s = jnp.einsum('bqhcd,bkhcd->bhcqk', qblk.astype(jnp.float32), kf)
        q_pos = bi * Q_BLOCK + jnp.arange(Q_BLOCK)
        mask = k_pos[None, :] <= q_pos[:, None]
        p = jax.nn.softmax(jnp.where(mask, s, NEG_INF), axis=-1)
        w = p[:, :, 0] - lam * p[:, :, 1]
        return jnp.einsum('bhqk,bkhd->bqhd', w, vf)

    o = lax.map(one_block, (qb, jnp.arange(nb)))
    o = o.transpose(1, 0, 2, 3, 4).reshape(B, S, H, 2 * Dh)
    o = rms_norm(o, subln_g) * (1.0 - lambda_init)
    return o.reshape(B, S, H * 2 * Dh).astype(v.dtype)


def dilated_window_attn(q, k, v, window, dilation):
    B, S, H, Dh = q.shape
    blk = window // dilation
    unit = blk * dilation
    s_pad = -(-S // unit) * unit
    lc = s_pad // dilation
    nb = lc // blk

    def to_blocks(t):
        t = jnp.pad(t.astype(jnp.float32), ((0, 0), (0, s_pad - S), (0, 0), (0, 0)))
        t = t.reshape(B, lc, dilation, H, Dh).transpose(0, 2, 3, 1, 4)
        return t.reshape(B, dilation, H, nb, blk, Dh)

    def with_prev(t):
        prev = jnp.pad(t[:, :, :, :-1], ((0, 0), (0, 0), (0, 0), (1, 0), (0, 0), (0, 0)))
        return jnp.concatenate([prev, t], axis=4)

    qb = to_blocks(q)
    k2 = with_prev(to_blocks(k))
    v2 = with_prev(to_blocks(v))
    s = jnp.einsum('brhnqd,brhnkd->brhnqk', qb, k2)
    qi = jnp.arange(blk)[:, None] + blk
    ki = jnp.arange(2 * blk)[None, :]
    dist = qi - ki
    band = (dist >= 0) & (dist <= blk)
    has_prev = (jnp.arange(nb)[:, None, None] > 0) | (ki[None] >= blk)
    mask = band[None] & has_prev
    s = jnp.where(mask, s, NEG_INF)
    m = jnp.max(s, axis=-1, keepdims=True)
    e = jnp.exp(s - m)
    den = jnp.sum(e, axis=-1)
    o = jnp.einsum('brhnqk,brhnkd->brhnqd', e, v2) / den[..., None]
    lse = m[..., 0] + jnp.log(den)
    o = o.reshape(B, dilation, H, lc, Dh).transpose(0, 3, 1, 2, 4).reshape(B, s_pad, H, Dh)[:, :S]
    lse = lse.reshape(B, dilation, H, lc).transpose(0, 3, 1, 2).reshape(B, s_pad, H)[:, :S]
    return o, lse


def hawk_diff_mixer(x, cos, sin, layer_idx, norm_g, w_in, conv_w, conv_b, wa, ba, wx, bx,
                    lru_lambda, q_norm_g, k_norm_g, lq1, lk1, lq2, lk2, subln_g, w_out):
    B, S, _ = x.shape
    h = rms_norm(x, norm_g)
    proj = h @ w_in
    cuts = np.cumsum([RNN_WIDTH, RNN_WIDTH, DIFF_QK_WIDTH, DIFF_QK_WIDTH]).tolist()
    xr, gate, q, k, v = jnp.split(proj, cuts, axis=-1)
    y_rnn = rglru_block(xr, gate, conv_w, conv_b, wa, ba, wx, bx, lru_lambda)
    q = q.reshape(B, S, DIFF_HEADS, 2, HEAD_DIM)
    k = k.reshape(B, S, DIFF_HEADS, 2, HEAD_DIM)
    v = v.reshape(B, S, DIFF_HEADS, DIFF_V_DIM)
    q = apply_partial_rope(rms_norm(q, q_norm_g), cos, sin) * (HEAD_DIM ** -0.5)
    k = apply_partial_rope(rms_norm(k, k_norm_g), cos, sin)
    lambda_init = 0.8 - 0.6 * math.exp(-0.3 * layer_idx)
    f32 = jnp.float32
    lam = (jnp.exp(jnp.sum(lq1.astype(f32) * lk1.astype(f32)))
           - jnp.exp(jnp.sum(lq2.astype(f32) * lk2.astype(f32))) + lambda_init)
    y_diff = diff_attention(q, k, v, lam, lambda_init, subln_g)
    return jnp.concatenate([y_rnn, y_diff], axis=-1) @ w_out


def dilated_mixer(x, cos, sin, norm_g, w_qkv, q_norm_g, k_norm_g, w_out):
    B, S, _ = x.shape
    h = rms_norm(x, norm_g)
    q, k, v = jnp.split(h @ w_qkv, 3, axis=-1)
    q = q.reshape(B, S, DIL_HEADS, HEAD_DIM)
    k = k.reshape(B, S, DIL_HEADS, HEAD_DIM)
    v = v.reshape(B, S, DIL_HEADS, HEAD_DIM)
    q = apply_partial_rope(rms_norm(q, q_norm_g), cos, sin) * (HEAD_DIM ** -0.5)
    k = apply_partial_rope(rms_norm(k, k_norm_g), cos, sin)
    outs = []
    lses = []
    for window, dilation in DIL_PATTERNS:
        o, lse = dilated_window_attn(q, k, v, window, dilation)
        outs.append(o)
        lses.append(lse)
    alpha = jax.nn.softmax(jnp.stack(lses), axis=0)
    o = jnp.einsum('gbsh,gbshd->bshd', alpha, jnp.stack(outs))
    return o.reshape(B, S, D_MODEL).astype(x.dtype) @ w_out


def swiglu(x, norm_g, w_gate, w_up, w_down):
    h = rms_norm(x, norm_g)
    return (jax.nn.silu(h @ w_gate) * (h @ w_up)) @ w_down


def setup_inputs(seed: int = 0) -> dict:
    key = jax.random.key(seed)
    ks = jax.random.split(key, 32)
    f32 = jnp.float32

    def normal(k, shape, scale):
        return jax.random.normal(k, shape, f32) * scale

    def gain(k, shape):
        return 1.0 + 0.02 * jax.random.normal(k, shape, f32)

    u = jax.random.uniform(ks[9], (N_EVEN, RNN_WIDTH), f32, minval=0.9, maxval=0.999)
    a0 = u ** (1.0 / RGLRU_C)
    lru_lambda = jnp.log(a0) - jnp.log1p(-a0)
    return {
        "x": jax.random.normal(ks[0], (BATCH, SEQ, D_MODEL), f32),
        "ab_norm_g": gain(ks[1], (N_EVEN, D_MODEL)),
        "ab_w_in": normal(ks[2], (N_EVEN, D_MODEL, AB_IN_WIDTH), D_MODEL ** -0.5),
        "ab_conv_w": normal(ks[3], (N_EVEN, CONV_WIDTH, RNN_WIDTH), CONV_WIDTH ** -0.5),
        "ab_conv_b": normal(ks[4], (N_EVEN, RNN_WIDTH), 0.01),
        "ab_wa": normal(ks[5], (N_EVEN, RNN_BLOCKS, RNN_BLOCK, RNN_BLOCK), RNN_BLOCK ** -0.5),
        "ab_ba": normal(ks[6], (N_EVEN, RNN_WIDTH), 0.01),
        "ab_wx": normal(ks[7], (N_EVEN, RNN_BLOCKS, RNN_BLOCK, RNN_BLOCK), RNN_BLOCK ** -0.5),
        "ab_bx": normal(ks[8], (N_EVEN, RNN_WIDTH), 0.01),
        "ab_lru_lambda": lru_lambda,
        "ab_q_norm_g": gain(ks[10], (N_EVEN, HEAD_DIM)),
        "ab_k_norm_g": gain(ks[11], (N_EVEN, HEAD_DIM)),
        "ab_lambda_q1": normal(ks[12], (N_EVEN, HEAD_DIM), 0.1),
        "ab_lambda_k1": normal(ks[13], (N_EVEN, HEAD_DIM), 0.1),
        "ab_lambda_q2": normal(ks[14], (N_EVEN, HEAD_DIM), 0.1),
        "ab_lambda_k2": normal(ks[15], (N_EVEN, HEAD_DIM), 0.1),
        "ab_subln_g": gain(ks[16], (N_EVEN, DIFF_V_DIM)),
        "ab_w_out": normal(ks[17], (N_EVEN, RNN_WIDTH + DIFF_WIDTH, D_MODEL), (RNN_WIDTH + DIFF_WIDTH) ** -0.5),
        "c_norm_g": gain(ks[18], (N_ODD, D_MODEL)),
        "c_w_qkv": normal(ks[19], (N_ODD, D_MODEL, 3 * D_MODEL), D_MODEL ** -0.5),
        "c_q_norm_g": gain(ks[20], (N_ODD, HEAD_DIM)),
        "c_k_norm_g": gain(ks[21], (N_ODD, HEAD_DIM)),
        "c_w_out": normal(ks[22], (N_ODD, D_MODEL, D_MODEL), D_MODEL ** -0.5),
        "ffn_norm_g": gain(ks[23], (DEPTH, D_MODEL)),
        "ffn_w_gate": normal(ks[24], (DEPTH, D_MODEL, D_FF), D_MODEL ** -0.5),
        "ffn_w_up": normal(ks[25], (DEPTH, D_MODEL, D_FF), D_MODEL ** -0.5),
        "ffn_w_down": normal(ks[26], (DEPTH, D_FF, D_MODEL), D_FF ** -0.5),
    }


def reference(x, ab_norm_g, ab_w_in, ab_conv_w, ab_conv_b, ab_wa, ab_ba, ab_wx, ab_bx,
              ab_lru_lambda, ab_q_norm_g, ab_k_norm_g, ab_lambda_q1, ab_lambda_k1,
              ab_lambda_q2, ab_lambda_k2, ab_subln_g, ab_w_out, c_norm_g, c_w_qkv,
              c_q_norm_g, c_k_norm_g, c_w_out, ffn_norm_g, ffn_w_gate, ffn_w_up, ffn_w_down):
    cos, sin = rope_tables(x.shape[1])
    for layer in range(DEPTH):
        j = layer // 2
        if layer % 2 == 0:
            x = x + hawk_diff_mixer(x, cos, sin, layer, ab_norm_g[j], ab_w_in[j], ab_conv_w[j],
                                    ab_conv_b[j], ab_wa[j], ab_ba[j], ab_wx[j], ab_bx[j],
                                    ab_lru_lambda[j], ab_q_norm_g[j], ab_k_norm_g[j],
                                    ab_lambda_q1[j], ab_lambda_k1[j], ab_lambda_q2[j],
                                    ab_lambda_k2[j], ab_subln_g[j], ab_w_out[j])
        else:
            x = x + dilated_mixer(x, cos, sin, c_norm_g[j], c_w_qkv[j], c_q_norm_g[j],
                                  c_k_norm_g[j], c_w_out[j])
        x = x + swiglu(x, ffn_norm_g[layer], ffn_w_gate[layer], ffn_w_up[layer], ffn_w_down[layer])
    return x
```

```cpp
#include <hip/hip_runtime.h>
#include <hip/hip_cooperative_groups.h>
#include <cstdio>
#include <cstdint>
namespace cg = cooperative_groups;
__device__ __forceinline__ int opaque_tid() { int t = threadIdx.x; asm volatile("" : "+v"(t)); return t; }
#define BAR_LDS() asm volatile("s_waitcnt lgkmcnt(0)\n\ts_barrier" ::: "memory")
namespace pg8 {
#define PG8_LAS __attribute__((address_space(3)))
typedef unsigned short bf16_t;
typedef short bf16x8 __attribute__((ext_vector_type(8)));
typedef float f32x4 __attribute__((ext_vector_type(4)));
typedef unsigned u32x4 __attribute__((ext_vector_type(4)));
constexpr int BM = 256, BK = 64, HALF = 128, HTB = HALF * BK * 2  , STAGE_BYTES = 8 * HTB, NXCD = 8, WGM = 4;

__host__ __device__ __forceinline__ int lds_byte(int r, int c) { const int st = (r >> 4) * 2 + (c >> 5), rr = r & 15, cc = c & 31, ob = rr * 64 + cc * 2; return st * 1024 + (ob ^ (((ob >> 9) & 1) << 5)); }
__host__ __device__ __forceinline__ void stage_rc(int b, int& R, int& C) { const int st = b / 1024, sb = b % 1024, swz = sb ^ (((sb >> 9) & 1) << 5); R = (st >> 1) * 16 + swz / 64; C = (st & 1) * 32 + (swz % 64) / 2; }
__host__ __device__ __forceinline__ int perm32(int rho) { const int n = rho >> 4, i = rho & 15; return 8 * (i >> 2) + 4 * n + (i & 3); }

struct Unit { int pm, pn; };
struct Gemm { const bf16_t* A; const bf16_t* Bt; int M, N, K; };

struct StaticOrder {
    int nM, nN, nwg, G, c;
    __host__ __device__ void init(int M, int N, int G_, int c_) { nM = M / BM; nN = N / BM; nwg = nM * nN; G = G_; c = c_; }
    __host__ __device__ bool next(int i, Unit& u) const {
        const long L = (long)i * G + c; if (L >= nwg) return false;
        int wgid = (int)L; { const int q = nwg / NXCD, r = nwg % NXCD, xcd = wgid % NXCD, off = wgid / NXCD; wgid = (xcd < r ? xcd * (q + 1) : r * (q + 1) + (xcd - r) * q) + off; }
        const int nig = WGM * nN, gid = wgid / nig, fm = gid * WGM, gsz = (nM - fm) < WGM ? (nM - fm) : WGM;
        u.pm = fm + ((wgid % nig) % gsz); u.pn = (wgid % nig) / gsz; return true;
    }
    __device__ __forceinline__ void a_ready(const Unit&) const {}
    __device__ __forceinline__ void done(const Unit&) const {}
};

__device__ __forceinline__ unsigned cvt_pk_bf16(float lo, float hi) { unsigned r; asm volatile("v_cvt_pk_bf16_f32 %0, %1, %2" : "=v"(r) : "v"(lo), "v"(hi)); return r; }
typedef float f32x2 __attribute__((ext_vector_type(2)));
__device__ __forceinline__ float sum_xor32(float x) { const unsigned u = __builtin_bit_cast(unsigned, x); auto r = __builtin_amdgcn_permlane32_swap(u, u, false, false); return __builtin_bit_cast(float, (unsigned)r[0]) + __builtin_bit_cast(float, (unsigned)r[1]); }
__device__ __forceinline__ float other_half(float x, bool upper) { const unsigned u = __builtin_bit_cast(unsigned, x); auto r = __builtin_amdgcn_permlane32_swap(u, u, false, false); return __builtin_bit_cast(float, (unsigned)(upper ? r[0] : r[1])); }
__device__ __forceinline__ float rstd_of(const float* ssq, int row) { return rsqrtf(ssq[row] * (1.0f / 1024.0f) + 1e-6f); }
typedef unsigned u32x2 __attribute__((ext_vector_type(2)));
struct EpiScale {
    static constexpr bool PERM = false, AFTER_DRAIN = false;
    bf16_t* O; int ldc; const float* ssq;
    __device__ __forceinline__ void operator()(const f32x4 (&acc)[2][2][4][2], const Unit& u, int wr, int wc, int fr, int fq) const {
        const int row0 = u.pm * BM + wr * 64 + fr, col0 = u.pn * BM + wc * 32 + 4 * fq;
#pragma unroll
        for (int ai = 0; ai < 2; ++ai)
#pragma unroll
            for (int m = 0; m < 4; ++m) { const int row = row0 + ai * HALF + m * 16; const float rs = rstd_of(ssq, row); bf16_t* rp = O + (size_t)row * ldc + col0;
#pragma unroll
                for (int bj = 0; bj < 2; ++bj)
#pragma unroll
                    for (int n = 0; n < 2; ++n) { const f32x4 v = acc[ai][bj][m][n] * rs; u32x2 w; w.x = cvt_pk_bf16(v[0], v[1]); w.y = cvt_pk_bf16(v[2], v[3]); *(u32x2*)(rp + bj * HALF + n * 16) = w; } }
    }
};
struct EpiResid {
    static constexpr bool PERM = false, AFTER_DRAIN = false;
    const float* xin; float* xout; bf16_t* xb; float* ssq_next;
    __device__ __forceinline__ void operator()(const f32x4 (&acc)[2][2][4][2], const Unit& u, int wr, int wc, int fr_in, int fq_in) const {
        int fr = fr_in, fq = fq_in; asm volatile("" : "+v"(fr), "+v"(fq));
        const int row0 = u.pm * BM + wr * 64 + fr, col0 = u.pn * BM + wc * 32 + 4 * fq;
#pragma unroll
        for (int ai = 0; ai < 2; ++ai) {
            f32x4 pre[4][2][2];
#pragma unroll
            for (int m = 0; m < 4; ++m) { const size_t off = (size_t)(row0 + ai * HALF + m * 16) * 1024 + col0;
#pragma unroll
                for (int bj = 0; bj < 2; ++bj)
#pragma unroll
                    for (int n = 0; n < 2; ++n) pre[m][bj][n] = *(const f32x4*)(xin + off + bj * HALF + n * 16); }
#pragma unroll
            for (int m = 0; m < 4; ++m) { const int row = row0 + ai * HALF + m * 16; const size_t off = (size_t)row * 1024 + col0; float s = 0.f;
#pragma unroll
                for (int bj = 0; bj < 2; ++bj)
#pragma unroll
                    for (int n = 0; n < 2; ++n) { const size_t o2 = off + bj * HALF + n * 16; const f32x4 x = pre[m][bj][n] + acc[ai][bj][m][n]; *(f32x4*)(xout + o2) = x;
                        if (xb) { u32x2 w; w.x = cvt_pk_bf16(x[0], x[1]); w.y = cvt_pk_bf16(x[2], x[3]); *(u32x2*)(xb + o2) = w; s += (x[0] * x[0] + x[1] * x[1]) + (x[2] * x[2] + x[3] * x[3]); } }
                if (xb) { s += __shfl_xor(s, 16); s = sum_xor32(s); if (fq == 0) __hip_atomic_fetch_add(ssq_next + row, s, __ATOMIC_RELAXED, __HIP_MEMORY_SCOPE_AGENT); } }
            asm volatile("" ::: "memory");
        }
    }
};
struct EpiSwiGLU {
    static constexpr bool PERM = false, AFTER_DRAIN = false;
    bf16_t* H; const float* ssq;
    __device__ __forceinline__ void operator()(const f32x4 (&acc)[2][2][4][2], const Unit& u, int wr, int wc, int fr, int fq) const {
        const int row0 = u.pm * BM + wr * 64 + fr, col0 = u.pn * HALF + wc * 32 + 4 * fq;
#pragma unroll
        for (int ai = 0; ai < 2; ++ai)
#pragma unroll
            for (int m = 0; m < 4; ++m) { const int row = row0 + ai * HALF + m * 16; const float rs = rstd_of(ssq, row); bf16_t* rp = H + (size_t)row * 2816 + col0;
#pragma unroll
                for (int n = 0; n < 2; ++n) { const f32x4 g = acc[ai][0][m][n] * rs, uu = acc[ai][1][m][n] * rs; float h[4];
#pragma unroll
                    for (int i = 0; i < 4; ++i) h[i] = g[i] * uu[i] * __builtin_amdgcn_rcpf(1.0f + __expf(-g[i]));
                    u32x2 w; w.x = cvt_pk_bf16(h[0], h[1]); w.y = cvt_pk_bf16(h[2], h[3]); *(u32x2*)(rp + n * 16) = w; } }
    }
};

struct EpiQK {
    static constexpr bool PERM = false, AFTER_DRAIN = false;
    bf16_t* O; int ldc; const float* ssq; int q_lo, q_hi, k_hi; const float* qg; const float* kg; const float* rc; const float* rsn; PG8_LAS float* X;
    __device__ __forceinline__ void operator()(const f32x4 (&acc)[2][2][4][2], const Unit& u, int wr, int wc, int fr_in, int fq_in) const {
        int fr = fr_in, fq = fq_in; asm volatile("" : "+v"(fr), "+v"(fq));
        const int row0 = u.pm * BM + wr * 64 + fr, col0 = u.pn * BM + wc * 32 + 4 * fq;
        const bool isq = (u.pn >= q_lo) && (u.pn < q_hi), isk = (u.pn >= q_hi) && (u.pn < k_hi);
        if (!(isq || isk)) {
#pragma unroll
            for (int ai = 0; ai < 2; ++ai)
#pragma unroll
                for (int m = 0; m < 4; ++m) { const int row = row0 + ai * HALF + m * 16; const float rs = rstd_of(ssq, row); bf16_t* rp = O + (size_t)row * ldc + col0;
#pragma unroll
                    for (int bj = 0; bj < 2; ++bj)
#pragma unroll
                        for (int n = 0; n < 2; ++n) { const f32x4 v = acc[ai][bj][m][n] * rs; u32x2 w; w.x = cvt_pk_bf16(v[0], v[1]); w.y = cvt_pk_bf16(v[2], v[3]); *(u32x2*)(rp + bj * HALF + n * 16) = w; } }
            return;
        }
#pragma unroll
        for (int ai = 0; ai < 2; ++ai)
#pragma unroll
            for (int m = 0; m < 4; ++m) { const int rl = ai * HALF + wr * 64 + m * 16 + fr;
#pragma unroll
                for (int bj = 0; bj < 2; ++bj) { float s = 0.f;
#pragma unroll
                    for (int n = 0; n < 2; ++n) { const f32x4 v = acc[ai][bj][m][n]; s += (v[0] * v[0] + v[1] * v[1]) + (v[2] * v[2] + v[3] * v[3]); }
                    s += __shfl_xor(s, 16); s = sum_xor32(s);
                    if (fq == 0) X[(rl * 2 + bj) * 4 + wc] = s; } }
        asm volatile("s_waitcnt lgkmcnt(0)\n\ts_barrier" ::: "memory");
        const float* g = isq ? qg : kg; const float scale = isq ? (0.125f * 1.4426950408889634f) : 1.0f;
        const f32x4 g0 = *(const f32x4*)(g + 32 * (wc & 1) + 4 * fq), g1 = *(const f32x4*)(g + 32 * (wc & 1) + 16 + 4 * fq);
        const bool rot = (wc & 1) == 0;
#pragma unroll
        for (int ai = 0; ai < 2; ++ai)
#pragma unroll
            for (int m = 0; m < 4; ++m) { const int rl = ai * HALF + wr * 64 + m * 16 + fr, row = u.pm * BM + rl; const float rs = rstd_of(ssq, row); bf16_t* rp = O + (size_t)row * ldc + col0;
                const int pos = row & 2047;
                f32x4 cv = {1.f, 1.f, 1.f, 1.f}, sv = {0.f, 0.f, 0.f, 0.f};
                if (rot) { cv = *(const f32x4*)(rc + pos * 8 + 4 * (fq & 1)); sv = *(const f32x4*)(rsn + pos * 8 + 4 * (fq & 1)); if (fq < 2) sv = -sv; }
#pragma unroll
                for (int bj = 0; bj < 2; ++bj) { const float hs = (X[(rl * 2 + bj) * 4 + wc] + X[(rl * 2 + bj) * 4 + (wc ^ 1)]) * (rs * rs);
                    const float hr = rsqrtf(hs * (1.0f / 64.0f) + 1e-6f) * rs;
                    f32x4 v0 = acc[ai][bj][m][0] * hr * g0, v1 = acc[ai][bj][m][1] * hr * g1;
                    f32x4 p; p[0] = other_half(v0[0], fq >= 2); p[1] = other_half(v0[1], fq >= 2); p[2] = other_half(v0[2], fq >= 2); p[3] = other_half(v0[3], fq >= 2);
                    v0 = v0 * cv + p * sv;
                    v0 = v0 * scale; v1 = v1 * scale;
                    u32x2 w0, w1; w0.x = cvt_pk_bf16(v0[0], v0[1]); w0.y = cvt_pk_bf16(v0[2], v0[3]); w1.x = cvt_pk_bf16(v1[0], v1[1]); w1.y = cvt_pk_bf16(v1[2], v1[3]);
                    *(u32x2*)(rp + bj * HALF) = w0; *(u32x2*)(rp + bj * HALF + 16) = w1; } }
    }
};

template <class Epi, class Sched, bool ALIGN_EPI = false, bool SP2 = false>
__device__ __forceinline__ void gemm_phase(PG8_LAS unsigned char* lds, const Gemm g, const Sched& S, const Epi& E) {
    const int tid = opaque_tid(), wid = __builtin_amdgcn_readfirstlane(tid >> 6), lane = tid & 63, wr = wid >> 2, wc = wid & 3, fr = lane & 15, fq = lane >> 4;
    const int K = g.K, nt = K / BK;
    unsigned voffA[2], voffB[2];
#pragma unroll
    for (int i = 0; i < 2; ++i) { int R, C; stage_rc(tid * 16 + i * 8192, R, C); const int Rb = Epi::PERM ? ((R & ~31) + perm32(R & 31)) : R;
        voffA[i] = (unsigned)(R * K + C) * 2u; voffB[i] = (unsigned)(Rb * K + C) * 2u; }
    const size_t kstep = (size_t)(BK * 2);
    const size_t hstep = (size_t)HALF * K * 2;
    const size_t tstep = 2 * hstep;
    const unsigned ldsw = (unsigned)wid * 1024u;
    const int aoff = lds_byte(wr * 64 + fr, fq * 8), boff = lds_byte(wc * 32 + fr, fq * 8);
#define PG8_SA(b, h) (((b) * 2 + (h)) * HTB)
#define PG8_SB(b, h) ((4 + (b) * 2 + (h)) * HTB)
#define PG8_STAGE(bufoff, gbase, voff) do { _Pragma("unroll") for (int _i = 0; _i < 2; ++_i) \
        __builtin_amdgcn_global_load_lds((const unsigned*)((const char*)(gbase) + (voff)[_i]), (PG8_LAS unsigned*)(lds + (bufoff) + ldsw + _i * 8192), 16, 0, 0); } while (0)
#define PG8_LDA(dst, b, h) do { _Pragma("unroll") for (int m = 0; m < 4; ++m) _Pragma("unroll") for (int k = 0; k < 2; ++k) dst[m][k] = *(const PG8_LAS bf16x8*)(lds + PG8_SA(b, h) + aoff + m * 2048 + k * 1024); } while (0)
#define PG8_LDB(dst, b, h) do { _Pragma("unroll") for (int n = 0; n < 2; ++n) _Pragma("unroll") for (int k = 0; k < 2; ++k) dst[n][k] = *(const PG8_LAS bf16x8*)(lds + PG8_SB(b, h) + boff + n * 2048 + k * 1024); } while (0)
#define PG8_MMA(ai, bj, At, Bt) do { __builtin_amdgcn_s_setprio(1); _Pragma("unroll") for (int m = 0; m < 4; ++m) _Pragma("unroll") for (int n = 0; n < 2; ++n) _Pragma("unroll") for (int k = 0; k < 2; ++k) \
        acc[ai][bj][m][n] = __builtin_amdgcn_mfma_f32_16x16x32_bf16(Bt[n][k], At[m][k], acc[ai][bj][m][n], 0, 0, 0); __builtin_amdgcn_s_setprio(0); } while (0)
#define PG8_WAIT_V(n) asm volatile("s_waitcnt vmcnt(" #n ")" ::: "memory")
#define PG8_WAIT_L(n) asm volatile("s_waitcnt lgkmcnt(" #n ")" ::: "memory")
#define PG8_BAR __builtin_amdgcn_s_barrier()
#define PG8_SCHED __builtin_amdgcn_sched_barrier(0)
    Unit cur, nxt; int ui = 0;
    if (!S.next(0, cur)) return;
    f32x4 acc[2][2][4][2];
#pragma unroll
    for (int a = 0; a < 2; ++a)
#pragma unroll
        for (int b = 0; b < 2; ++b)
#pragma unroll
            for (int m = 0; m < 4; ++m)
#pragma unroll
                for (int n = 0; n < 2; ++n) acc[a][b][m][n] = (f32x4){0.f, 0.f, 0.f, 0.f};
    bf16x8 At[4][2], B0[2][2], B1[2][2];
    const char* cA = (const char*)g.A + (size_t)cur.pm * tstep; const char* cB = (const char*)g.Bt + (size_t)cur.pn * tstep;
    S.a_ready(cur);
    if constexpr (SP2) {
        PG8_STAGE(PG8_SB(0, 0), cB, voffB); PG8_STAGE(PG8_SB(0, 1), cB + hstep, voffB); PG8_STAGE(PG8_SA(0, 0), cA, voffA); PG8_STAGE(PG8_SA(0, 1), cA + hstep, voffA);
        if (wr == 1) PG8_BAR;
        PG8_WAIT_V(2); PG8_BAR;
        PG8_STAGE(PG8_SB(1, 0), cB + kstep, voffB); PG8_STAGE(PG8_SA(1, 0), cA + kstep, voffA); PG8_STAGE(PG8_SB(1, 1), cB + hstep + kstep, voffB);
        PG8_WAIT_V(6); PG8_BAR;
    } else {
        PG8_STAGE(PG8_SB(0, 0), cB, voffB); PG8_STAGE(PG8_SA(0, 0), cA, voffA); PG8_STAGE(PG8_SB(0, 1), cB + hstep, voffB); PG8_STAGE(PG8_SA(0, 1), cA + hstep, voffA);
        if (wr == 1) PG8_BAR;
        PG8_WAIT_V(4); PG8_BAR;
        PG8_STAGE(PG8_SB(1, 0), cB + kstep, voffB); PG8_STAGE(PG8_SA(1, 0), cA + kstep, voffA); PG8_STAGE(PG8_SB(1, 1), cB + hstep + kstep, voffB);
        PG8_WAIT_V(6); PG8_BAR;
    }
    for (;;) {
        const bool has_next = S.next(ui + 1, nxt);
        const char* nA = has_next ? (const char*)g.A + (size_t)nxt.pm * tstep : cA; const char* nB = has_next ? (const char*)g.Bt + (size_t)nxt.pn * tstep : cB;
        for (int t = 0; t < nt; t += 2) {
            const bool last = (t == nt - 2);
            const char* a1 = cA + (size_t)(t + 1) * kstep;
            const char* a2 = last ? nA : cA + (size_t)(t + 2) * kstep; const char* b2 = last ? nB : cB + (size_t)(t + 2) * kstep;
            const char* a3 = a2 + kstep; const char* b3 = b2 + kstep;
            if (last && has_next) S.a_ready(nxt);
            if constexpr (SP2) {
            PG8_LDB(B0, 0, 0); PG8_LDB(B1, 0, 1); PG8_SCHED; PG8_LDA(At, 0, 0); PG8_STAGE(PG8_SA(1, 1), a1 + hstep, voffA);
            PG8_WAIT_V(8); PG8_WAIT_L(0); PG8_BAR; PG8_MMA(0, 0, At, B0); PG8_MMA(0, 1, At, B1); PG8_BAR; PG8_SCHED;
            PG8_LDA(At, 0, 1); PG8_STAGE(PG8_SB(0, 0), b2, voffB); PG8_STAGE(PG8_SB(0, 1), b2 + hstep, voffB); PG8_STAGE(PG8_SA(0, 0), a2, voffA);
            PG8_WAIT_V(8); PG8_WAIT_L(0); PG8_BAR; PG8_MMA(1, 0, At, B0); PG8_MMA(1, 1, At, B1); PG8_BAR; PG8_SCHED;
            PG8_LDB(B0, 1, 0); PG8_LDB(B1, 1, 1); PG8_SCHED; PG8_LDA(At, 1, 0); PG8_STAGE(PG8_SA(0, 1), a2 + hstep, voffA);
            PG8_WAIT_V(8); PG8_WAIT_L(0); PG8_BAR; PG8_MMA(0, 0, At, B0); PG8_MMA(0, 1, At, B1); PG8_BAR; PG8_SCHED;
            PG8_LDA(At, 1, 1); PG8_STAGE(PG8_SB(1, 0), b3, voffB); PG8_STAGE(PG8_SB(1, 1), b3 + hstep, voffB); PG8_STAGE(PG8_SA(1, 0), a3, voffA);
            PG8_WAIT_V(8); PG8_WAIT_L(0); PG8_BAR; PG8_MMA(1, 0, At, B0); PG8_MMA(1, 1, At, B1); PG8_BAR; PG8_SCHED;
            } else {
            PG8_LDB(B0, 0, 0); PG8_SCHED; PG8_LDA(At, 0, 0); PG8_STAGE(PG8_SA(1, 1), a1 + hstep, voffA);
            PG8_WAIT_L(8); PG8_BAR; PG8_WAIT_L(0); PG8_MMA(0, 0, At, B0); PG8_BAR; PG8_SCHED;
            PG8_LDB(B1, 0, 1); PG8_STAGE(PG8_SB(0, 0), b2, voffB);
            PG8_BAR; PG8_WAIT_L(0); PG8_MMA(0, 1, At, B1); PG8_BAR;
            PG8_LDA(At, 0, 1); PG8_STAGE(PG8_SA(0, 0), a2, voffA);
            PG8_BAR; PG8_WAIT_L(0); PG8_MMA(1, 0, At, B0); PG8_BAR; PG8_SCHED;
            PG8_STAGE(PG8_SB(0, 1), b2 + hstep, voffB);
            PG8_WAIT_V(6); PG8_BAR; PG8_MMA(1, 1, At, B1); PG8_BAR;
            PG8_LDB(B0, 1, 0); PG8_SCHED; PG8_LDA(At, 1, 0); PG8_STAGE(PG8_SA(0, 1), a2 + hstep, voffA);
            PG8_WAIT_L(8); PG8_BAR; PG8_WAIT_L(0); PG8_MMA(0, 0, At, B0); PG8_BAR; PG8_SCHED;
            PG8_LDB(B1, 1, 1); PG8_STAGE(PG8_SB(1, 0), b3, voffB);
            PG8_BAR; PG8_WAIT_L(0); PG8_MMA(0, 1, At, B1); PG8_BAR;
            PG8_LDA(At, 1, 1); PG8_STAGE(PG8_SA(1, 0), a3, voffA);
            PG8_BAR; PG8_WAIT_L(0); PG8_MMA(1, 0, At, B0); PG8_BAR; PG8_SCHED;
            PG8_STAGE(PG8_SB(1, 1), b3 + hstep, voffB);
            PG8_WAIT_V(6); PG8_BAR; PG8_MMA(1, 1, At, B1); PG8_BAR;
            }
        }
        if constexpr (ALIGN_EPI) { if (wr == 0) PG8_BAR; }
        if constexpr (!Epi::AFTER_DRAIN) { E(acc, cur, wr, wc, fr, fq); S.done(cur); }
        if (!has_next) break;
#pragma unroll
        for (int a = 0; a < 2; ++a)
#pragma unroll
            for (int b = 0; b < 2; ++b)
#pragma unroll
                for (int m = 0; m < 4; ++m)
#pragma unroll
                    for (int n = 0; n < 2; ++n) acc[a][b][m][n] = (f32x4){0.f, 0.f, 0.f, 0.f};
        cur = nxt; cA = nA; cB = nB; ++ui;
        if constexpr (ALIGN_EPI) { if (wr == 1) PG8_BAR; }
    }
    PG8_WAIT_V(0);
    if constexpr (!ALIGN_EPI) { if (wr == 0) PG8_BAR; }
    PG8_BAR;
    if constexpr (Epi::AFTER_DRAIN) { E.fused(acc, cur, wr, wc, fr, fq, lds, wid, lane); S.done(cur); }
#undef PG8_SA
#undef PG8_SB
#undef PG8_STAGE
#undef PG8_LDA
#undef PG8_LDB
#undef PG8_MMA
#undef PG8_WAIT_V
#undef PG8_WAIT_L
#undef PG8_BAR
#undef PG8_SCHED
}
}
#define LAS __attribute__((address_space(3)))
typedef unsigned short bf16;
typedef short bf16x8 __attribute__((ext_vector_type(8)));
typedef float f32x4 __attribute__((ext_vector_type(4)));
typedef unsigned u32x4 __attribute__((ext_vector_type(4)));
typedef unsigned u32x2 __attribute__((ext_vector_type(2)));
constexpr int BATCH = 16, SEQ = 2048, DM = 1024, MROWS = BATCH * SEQ, DFF = 2816, NIN = 2560, NQKV = 3072;
constexpr size_t MiB = 1u << 20;
constexpr size_t WS_CTL = 0;
constexpr size_t WS_ROPE = 1 * MiB;
constexpr size_t WS_SSQ = 2 * MiB;
constexpr size_t WS_LSE = 4 * MiB;
constexpr size_t WS_WIN = 16 * MiB, WS_WO0 = 22 * MiB, WS_WGU0 = 24 * MiB, WS_WDN0 = 36 * MiB, WS_WQKV = 42 * MiB, WS_WO1 = 48 * MiB, WS_WGU1 = 50 * MiB, WS_WDN1 = 62 * MiB;
constexpr size_t WS_XB = 68 * MiB;
constexpr size_t WS_A = 132 * MiB;
constexpr size_t WS_B = 324 * MiB;
constexpr size_t WS_C = 388 * MiB;
constexpr size_t WS_END = 452 * MiB;
constexpr int LDS_BYTES = 147456 + 256;
constexpr int LDS_ITEM = 147456;
constexpr int LDS_BARST = 147456 + 64;
constexpr int CW_BAR = 4096;

struct Args { const float* in[27]; float* out; unsigned char* ws; };

__device__ __forceinline__ unsigned cvtpk(float lo, float hi) { typedef float f2 __attribute__((ext_vector_type(2))); typedef __bf16 b2 __attribute__((ext_vector_type(2))); f2 v = {lo, hi}; b2 b = __builtin_convertvector(v, b2); return __builtin_bit_cast(unsigned, b); }
__device__ __forceinline__ float bflo(unsigned u) { return __uint_as_float(u << 16); }
__device__ __forceinline__ float bfhi(unsigned u) { return __uint_as_float(u & 0xffff0000u); }
__device__ __forceinline__ float wave_sum(float v) {
#pragma unroll
    for (int o = 1; o < 64; o <<= 1) v += __shfl_xor(v, o);
    return v;
}
#define LDS_WAIT() asm volatile("s_waitcnt lgkmcnt(0)" ::: "memory")

struct TrItem { const float* W; bf16* WT; const float* gain; int K, N, mode, r; };
__device__ __forceinline__ TrItem tr_decode(const Args& a, int it) {
    constexpr int I_IN = 32 * (NIN / 128), I_O = 32 * 8, I_G = 32 * (DFF / 128), I_D = (DFF / 32) * 8, I_Q = 32 * (NQKV / 128);
    unsigned char* ws = a.ws; int r = it; TrItem d;
    if (r < I_IN) { d = TrItem{a.in[2], (bf16*)(ws + WS_WIN), a.in[1], DM, NIN, 0, r}; return d; } r -= I_IN;
    if (r < I_O) { d = TrItem{a.in[17], (bf16*)(ws + WS_WO0), nullptr, DM, DM, 0, r}; return d; } r -= I_O;
    if (r < I_G) { d = TrItem{a.in[24], (bf16*)(ws + WS_WGU0), a.in[23], DM, DFF, 1, r}; return d; } r -= I_G;
    if (r < I_G) { d = TrItem{a.in[25], (bf16*)(ws + WS_WGU0), a.in[23], DM, DFF, 2, r}; return d; } r -= I_G;
    if (r < I_D) { d = TrItem{a.in[26], (bf16*)(ws + WS_WDN0), nullptr, DFF, DM, 0, r}; return d; } r -= I_D;
    if (r < I_Q) { d = TrItem{a.in[19], (bf16*)(ws + WS_WQKV), a.in[18], DM, NQKV, 0, r}; return d; } r -= I_Q;
    if (r < I_O) { d = TrItem{a.in[22], (bf16*)(ws + WS_WO1), nullptr, DM, DM, 0, r}; return d; } r -= I_O;
    if (r < I_G) { d = TrItem{a.in[24] + (size_t)DM * DFF, (bf16*)(ws + WS_WGU1), a.in[23] + DM, DM, DFF, 1, r}; return d; } r -= I_G;
    if (r < I_G) { d = TrItem{a.in[25] + (size_t)DM * DFF, (bf16*)(ws + WS_WGU1), a.in[23] + DM, DM, DFF, 2, r}; return d; } r -= I_G;
    d = TrItem{a.in[26] + (size_t)DFF * DM, (bf16*)(ws + WS_WDN1), nullptr, DFF, DM, 0, r}; return d;
}
__device__ __forceinline__ void tr_load(const TrItem& d, int lane, f32x4 (&v)[16]) {
    const int nblk = d.N / 128, kb = d.r / nblk, nb = d.r % nblk, k0 = 32 * kb, n0 = 128 * nb;
#pragma unroll
    for (int i = 0; i < 16; ++i) { const int kk = 2 * i + (lane >> 5); v[i] = *(const f32x4*)(d.W + (size_t)(k0 + kk) * d.N + n0 + 4 * (lane & 31)); }
}
__device__ __forceinline__ void tr_store(const TrItem& d, int lane, const f32x4 (&v)[16], LAS float* scr) {
    const int nblk = d.N / 128, kb = d.r / nblk, nb = d.r % nblk, k0 = 32 * kb, n0 = 128 * nb;
#pragma unroll
    for (int i = 0; i < 16; ++i) { const int kk = 2 * i + (lane >> 5); const float gv = d.gain ? d.gain[k0 + kk] : 1.0f; *(LAS f32x4*)(scr + kk * 132 + 4 * (lane & 31)) = v[i] * gv; }
    LDS_WAIT();
    const int rbase = (d.mode == 0) ? n0 : (256 * (n0 >> 7) + (d.mode == 2 ? 128 : 0));
#pragma unroll
    for (int h = 0; h < 2; ++h) { const int n = lane + 64 * h; const LAS float* s = scr + n; u32x4* dst = (u32x4*)(d.WT + (size_t)(rbase + n) * d.K + k0);
#pragma unroll
        for (int q = 0; q < 4; ++q) { u32x4 o; o.x = cvtpk(s[(8 * q + 0) * 132], s[(8 * q + 1) * 132]); o.y = cvtpk(s[(8 * q + 2) * 132], s[(8 * q + 3) * 132]); o.z = cvtpk(s[(8 * q + 4) * 132], s[(8 * q + 5) * 132]); o.w = cvtpk(s[(8 * q + 6) * 132], s[(8 * q + 7) * 132]); dst[q] = o; } }
    LDS_WAIT();
}
__device__ __forceinline__ void p0_prologue(const Args& a, LAS unsigned char* lds) {
    const int tid = opaque_tid(), lane = tid & 63, wave = __builtin_amdgcn_readfirstlane(tid >> 6);
    unsigned char* ws = a.ws;
    LAS float* scr = (LAS float*)(lds + wave * 17408);
    const int gw = blockIdx.x * 8 + wave, NGW = gridDim.x * 8;
    constexpr int NITEMS = 32 * (NIN / 128) + 2 * 32 * 8 + 4 * 32 * (DFF / 128) + 2 * (DFF / 32) * 8 + 32 * (NQKV / 128);
    { f32x4 va[16], vb[16];
      int it = gw; TrItem cur = tr_decode(a, it < NITEMS ? it : 0);
      if (it < NITEMS) tr_load(cur, lane, va);
      while (it < NITEMS) {
          const int i1 = it + NGW; TrItem d1 = cur; if (i1 < NITEMS) { d1 = tr_decode(a, i1); tr_load(d1, lane, vb); }
          tr_store(cur, lane, va, scr);
          if (i1 >= NITEMS) break;
          const int i2 = i1 + NGW; if (i2 < NITEMS) { cur = tr_decode(a, i2); tr_load(cur, lane, va); }
          tr_store(d1, lane, vb, scr);
          it = i2;
      } }
    const float* x = a.in[0]; bf16* xb = (bf16*)(ws + WS_XB); float* ssq = (float*)(ws + WS_SSQ);
    for (int m0 = gw * 4; m0 < MROWS; m0 += NGW * 4) {
        f32x4 v[4][4];
#pragma unroll
        for (int r = 0; r < 4; ++r)
#pragma unroll
            for (int j = 0; j < 4; ++j) v[r][j] = ((const f32x4*)(x + (size_t)(m0 + r) * DM) + lane)[64 * j];
#pragma unroll
        for (int r = 0; r < 4; ++r) { unsigned long long* o8 = (unsigned long long*)(xb + (size_t)(m0 + r) * DM) + lane; float s = 0.f;
#pragma unroll
            for (int j = 0; j < 4; ++j) { const f32x4 q = v[r][j]; s += (q[0] * q[0] + q[1] * q[1]) + (q[2] * q[2] + q[3] * q[3]); o8[64 * j] = (unsigned long long)cvtpk(q[0], q[1]) | ((unsigned long long)cvtpk(q[2], q[3]) << 32); }
            s = wave_sum(s);
            if (lane == 0) ssq[m0 + r] = s; }
    }
    const int gt = blockIdx.x * 512 + tid, NGT = gridDim.x * 512;
    for (int i = gt; i < 3 * MROWS; i += NGT) ssq[MROWS + i] = 0.f;
    for (int i = gt; i < 16384; i += NGT) ((unsigned*)(ws + WS_CTL))[i] = 0u;
    float* rc = (float*)(ws + WS_ROPE); float* rsn = rc + SEQ * 8;
    for (int i = gt; i < SEQ * 8; i += NGT) { const int pos = i >> 3, j = i & 7; const float inv = exp2f(-2.3664460711655217f * (float)j); const float ang = (float)pos * inv; double rev = (double)ang * 0.15915494309189535; rev -= rint(rev); rc[i] = __builtin_amdgcn_cosf((float)rev); rsn[i] = __builtin_amdgcn_sinf((float)rev); }
}
#define XB_TMO      128
#define XB_XCNT(j)  (256  + 64 * (j))
#define XB_XSUB(j)  (1280 + 64 * (j))
#define XB_XGEN(j)  (2304 + 64 * (j))
#define XB_TOP      3328
#define XB_TOPGEN   3392
#define XCD_BAR_WORDS 3456
#define XB_SPIN_CAP (1u << 18)

__device__ __forceinline__ unsigned xb_ld(unsigned* p)              { return __hip_atomic_load(p, __ATOMIC_RELAXED, __HIP_MEMORY_SCOPE_AGENT); }
__device__ __forceinline__ unsigned xb_add(unsigned* p, unsigned v) { return __hip_atomic_fetch_add(p, v, __ATOMIC_RELAXED, __HIP_MEMORY_SCOPE_AGENT); }
__device__ __forceinline__ unsigned xb_xcc_id() { return (unsigned)__builtin_amdgcn_s_getreg((3 << 11) | 20) & 0xFu; }
#define XB_SPIN(cond, bar) do { unsigned _sp = 0; while (cond) { __builtin_amdgcn_s_sleep(1); \
    if ((++_sp & 255u) == 0u) { if (xb_ld(&(bar)[XB_TMO])) break; if (_sp > XB_SPIN_CAP) { atomicAdd(&(bar)[XB_TMO], 1u); break; } } } } while (0)

struct XcdBarrier {
    unsigned* bar; unsigned x;
    volatile LAS unsigned* st;
};

__device__ __forceinline__ XcdBarrier xcd_barrier_post(unsigned* bar, volatile LAS unsigned* st) {
    XcdBarrier b; b.bar = bar; b.x = xb_xcc_id(); b.st = st;
    if (threadIdx.x == 0) (void)xb_add(&bar[XB_XCNT(b.x)], 1u);
    return b;
}
__device__ __forceinline__ void xcd_barrier_complete(unsigned* bar, unsigned x, unsigned& nloc, unsigned& nx) {
    const unsigned G = gridDim.x * gridDim.y * gridDim.z;
    unsigned sum, cnt, mine, sp = 0u;
    for (;;) {
        sum = 0u; cnt = 0u; mine = 0u;
#pragma unroll
        for (unsigned j = 0; j < 16; ++j) { const unsigned c = xb_ld(&bar[XB_XCNT(j)]); sum += c; cnt += (c > 0u) ? 1u : 0u; mine = (j == x) ? c : mine; }
        if (sum == G) break;
        __builtin_amdgcn_s_sleep(1);
        if ((++sp & 255u) == 0u) { if (xb_ld(&bar[XB_TMO])) break; if (sp > XB_SPIN_CAP) { atomicAdd(&bar[XB_TMO], 1u); break; } }
    }
    nloc = mine > 0u ? mine : 1u; nx = cnt > 0u ? cnt : 1u;
}

__device__ __forceinline__ void xcd_barrier(const XcdBarrier& b) {
    asm volatile("s_waitcnt vmcnt(0)" ::: "memory");
    __syncthreads();
    if (threadIdx.x == 0) {
        unsigned* bar = b.bar;
        __builtin_amdgcn_s_waitcnt(0);
        unsigned nloc = b.st[0], nx = b.st[1];
        if (nloc == 0u) { xcd_barrier_complete(bar, b.x, nloc, nx); b.st[0] = nloc; b.st[1] = nx; }
        const unsigned old = xb_add(&bar[XB_XSUB(b.x)], 1u);
        const unsigned gen = old / nloc;
        if (old + 1u == (gen + 1u) * nloc) {
            __builtin_amdgcn_fence(__ATOMIC_RELEASE, "agent");
            asm volatile("s_waitcnt vmcnt(0)" ::: "memory");
            const unsigned og = xb_add(&bar[XB_TOP], 1u);
            const unsigned tg = og / nx;
            if (og + 1u == (tg + 1u) * nx) xb_add(&bar[XB_TOPGEN], 1u);
            else XB_SPIN(xb_ld(&bar[XB_TOPGEN]) == tg, bar);
            __builtin_amdgcn_fence(__ATOMIC_ACQUIRE, "agent");
            xb_add(&bar[XB_XGEN(b.x)], 1u);
            asm volatile("s_waitcnt vmcnt(0)" ::: "memory");
        } else {
            XB_SPIN(xb_ld(&bar[XB_XGEN(b.x)]) == gen, bar);
            __builtin_amdgcn_fence(__ATOMIC_ACQUIRE, "agent");
            asm volatile("s_waitcnt vmcnt(0)" ::: "memory");
        }
    }
    __syncthreads();
}

__device__ __forceinline__ void rglru_unit(LAS unsigned char* lds, const Args& a, int b, int g) {
    const int tid = opaque_tid(), lane = tid & 63, w = __builtin_amdgcn_readfirstlane(tid >> 6), lg = lane >> 4, li = lane & 15;
    LAS bf16* Ub = (LAS bf16*)(lds);
    LAS bf16* Wat = (LAS bf16*)(lds + 18432);
    LAS bf16* Wxt = (LAS bf16*)(lds + 27648);
    constexpr int FP = 68;
    LAS float* Uf = (LAS float*)(lds + 36864);
    LAS float* Af = (LAS float*)(lds + 36864 + 34816);
    LAS float* Bf = (LAS float*)(lds + 36864 + 2 * 34816);
    LAS float* Pap = (LAS float*)(lds + 141312);
    LAS float* Phl = (LAS float*)(lds + 143360);
    LAS float* Car = (LAS float*)(lds + 145408);
    const bf16* proj = (const bf16*)(a.ws + WS_A) + (size_t)b * SEQ * NIN;
    bf16* ycat = (bf16*)(a.ws + WS_B) + (size_t)b * SEQ * DM;
    const float* wa = a.in[5] + (size_t)g * 4096; const float* wx = a.in[7] + (size_t)g * 4096;
#pragma unroll
    for (int e = 0; e < 8; ++e) { const int idx = tid + 512 * e, i = idx >> 6, j = idx & 63; Wat[j * 72 + i] = (bf16)(cvtpk(wa[idx], 0.f) & 0xffffu); Wxt[j * 72 + i] = (bf16)(cvtpk(wx[idx], 0.f) & 0xffffu); }
    if (tid < 64) Car[tid] = 0.f;
    const int c2 = tid & 31, tg = tid >> 5, ch0 = 64 * g + 2 * c2;
    float cw[4][2], cb[2];
#pragma unroll
    for (int j = 0; j < 4; ++j) { cw[j][0] = a.in[3][j * 512 + ch0]; cw[j][1] = a.in[3][j * 512 + ch0 + 1]; }
    cb[0] = a.in[4][ch0]; cb[1] = a.in[4][ch0 + 1];
    float cba[4], cbx[4], csp[4];
#pragma unroll
    for (int nt = 0; nt < 4; ++nt) { const int ch = 64 * g + 16 * nt + li; cba[nt] = a.in[6][ch]; cbx[nt] = a.in[8][ch]; const float lam = a.in[9][ch]; csp[nt] = log1pf(__expf(-lam)); }
    const int sc = lane, ss = w;
    unsigned xwr[11];
#pragma unroll
    for (int i = 0; i < 11; ++i) { const int tok = tg * 8 + i - 3; xwr[i] = tok >= 0 ? *(const unsigned*)(proj + (size_t)tok * NIN + ch0) : 0u; }
    for (int ck = 0; ck < SEQ / 128; ++ck) {
        const int s0 = ck * 128;
        BAR_LDS();
        { float xw[11][2];
#pragma unroll
          for (int i = 0; i < 11; ++i) { xw[i][0] = bflo(xwr[i]); xw[i][1] = bfhi(xwr[i]); }
          if (ck + 1 < SEQ / 128) {
#pragma unroll
              for (int i = 0; i < 11; ++i) xwr[i] = *(const unsigned*)(proj + (size_t)(s0 + 128 + tg * 8 + i - 3) * NIN + ch0); }
#pragma unroll
          for (int i = 0; i < 8; ++i) { float u0 = cb[0], u1 = cb[1];
#pragma unroll
              for (int j = 0; j < 4; ++j) { u0 += cw[j][0] * xw[i + j][0]; u1 += cw[j][1] * xw[i + j][1]; }
              const int t = tg * 8 + i; Uf[t * FP + 2 * c2] = u0; Uf[t * FP + 2 * c2 + 1] = u1; *(LAS unsigned*)(Ub + t * 72 + 2 * c2) = cvtpk(u0, u1); } }
        BAR_LDS();
        f32x4 accR[4], accI[4];
#pragma unroll
        for (int nt = 0; nt < 4; ++nt) { accR[nt] = (f32x4){0.f, 0.f, 0.f, 0.f}; accI[nt] = (f32x4){0.f, 0.f, 0.f, 0.f}; }
#pragma unroll
        for (int ks = 0; ks < 2; ++ks) { const bf16x8 af = *(const LAS bf16x8*)(Ub + (16 * w + li) * 72 + 32 * ks + 8 * lg);
#pragma unroll
            for (int nt = 0; nt < 4; ++nt) { const bf16x8 b1 = *(const LAS bf16x8*)(Wat + (16 * nt + li) * 72 + 32 * ks + 8 * lg), b2 = *(const LAS bf16x8*)(Wxt + (16 * nt + li) * 72 + 32 * ks + 8 * lg);
                accR[nt] = __builtin_amdgcn_mfma_f32_16x16x32_bf16(af, b1, accR[nt], 0, 0, 0); accI[nt] = __builtin_amdgcn_mfma_f32_16x16x32_bf16(af, b2, accI[nt], 0, 0, 0); } }
#pragma unroll
        for (int nt = 0; nt < 4; ++nt)
#pragma unroll
            for (int i = 0; i < 4; ++i) { const int t = 16 * w + 4 * lg + i, c = 16 * nt + li;
                const float r = __builtin_amdgcn_rcpf(1.0f + __expf(-(accR[nt][i] + cba[nt]))), ig = __builtin_amdgcn_rcpf(1.0f + __expf(-(accI[nt][i] + cbx[nt])));
                const float la = -8.0f * r * csp[nt]; const float av = __expf(la); const float bv = __builtin_amdgcn_sqrtf(fmaxf(fmaf(-av, av, 1.0f), 0.f)) * (ig * Uf[t * FP + c]);
                Af[t * FP + c] = av; Bf[t * FP + c] = bv; }
        unsigned short gv[16];
#pragma unroll
        for (int i = 0; i < 16; ++i) gv[i] = proj[(size_t)(s0 + 16 * ss + i) * NIN + 512 + 64 * g + sc];
        BAR_LDS();
        float hl[16], ap[16]; { float h = 0.f, p = 1.f;
#pragma unroll
          for (int i = 0; i < 16; ++i) { const float av = Af[(16 * ss + i) * FP + sc], bv = Bf[(16 * ss + i) * FP + sc]; h = av * h + bv; p *= av; hl[i] = h; ap[i] = p; }
          Pap[ss * 64 + sc] = p; Phl[ss * 64 + sc] = h; }
        BAR_LDS();
        float hin = Car[(ck & 1) * 64 + sc];
        for (int j = 0; j < ss; ++j) hin = Pap[j * 64 + sc] * hin + Phl[j * 64 + sc];
#pragma unroll
        for (int i = 0; i < 16; ++i) { const float h = hl[i] + ap[i] * hin; const float x = bflo(gv[i]); const float z = 0.7978845608028654f * (x + 0.044715f * x * x * x);
            const float ge = x * __builtin_amdgcn_rcpf(1.0f + __expf(-2.0f * z)); ycat[(size_t)(s0 + 16 * ss + i) * DM + 64 * g + sc] = (bf16)(cvtpk(h * ge, 0.f) & 0xffffu);
            if (i == 15 && ss == 7) Car[((ck + 1) & 1) * 64 + sc] = h; }
    }
    BAR_LDS();
}
typedef short v4i16_t __attribute__((ext_vector_type(4)));
__device__ __forceinline__ u32x2 tr_read4(const LAS bf16* p) { return __builtin_bit_cast(u32x2, __builtin_amdgcn_ds_read_tr16_b64_v4i16((LAS v4i16_t*)p)); }
__device__ __forceinline__ float score_bound(const float* qg, const float* kg, int lane) {
    float a = fabsf(qg[lane]), b = fabsf(kg[lane]);
#pragma unroll
    for (int o = 1; o < 64; o <<= 1) { a = fmaxf(a, __shfl_xor(a, o)); b = fmaxf(b, __shfl_xor(b, o)); }
    return 8.0f * 1.4426950408889634f * a * b * 1.01f + 0.5f;
}
struct AttnArgs {
    const bf16* Q; const bf16* K; const bf16* V; int ld;
    int qc0, T1;
    bf16* O; int ldo; float lam; const float* subg; float mb;
};
__device__ __forceinline__ void diff_unit(LAS unsigned char* lds, const AttnArgs A) {
    constexpr int NC = 2, DV = 128, QP = NC * 64 + 8, VP = DV + 16, NDT = DV / 16, NVH = DV / 64;
    const int tid = opaque_tid(), lane = tid & 63, w = __builtin_amdgcn_readfirstlane(tid >> 6), lg = lane >> 4, li = lane & 15;
    constexpr int TBUF = 64 * QP + 64 * VP;
    const int krow = tid >> 3, c8 = tid & 7;
    u32x4 kraw[NC], vraw[NVH];
#define ATT_LOAD(T) do { const int tk_ = 64 * (T) + krow; \
        _Pragma("unroll") for (int c = 0; c < NC; ++c) kraw[c] = *(const u32x4*)(A.K + (size_t)tk_ * A.ld + c * 64 + 8 * c8); \
        _Pragma("unroll") for (int hh = 0; hh < NVH; ++hh) vraw[hh] = *(const u32x4*)(A.V + (size_t)tk_ * A.ld + hh * 64 + 8 * c8); } while (0)
#define ATT_WRITE(buf) do { LAS bf16* Ks_ = (LAS bf16*)lds + (buf) * TBUF; LAS bf16* Vs_ = Ks_ + 64 * QP; \
        _Pragma("unroll") for (int c = 0; c < NC; ++c) *(LAS u32x4*)(Ks_ + krow * QP + c * 64 + 8 * c8) = kraw[c]; \
        _Pragma("unroll") for (int hh = 0; hh < NVH; ++hh) *(LAS u32x4*)(Vs_ + krow * VP + hh * 64 + 8 * c8) = vraw[hh]; } while (0)
    ATT_LOAD(0);
    const int qw = A.qc0 + 16 * w, qc = qw + li;
    bf16x8 qf[NC][2];
#pragma unroll
    for (int c = 0; c < NC; ++c)
#pragma unroll
        for (int ks = 0; ks < 2; ++ks) qf[c][ks] = *(const bf16x8*)(A.Q + (size_t)qc * A.ld + c * 64 + 32 * ks + 8 * lg);
    float lrun[NC]; f32x4 O[NC][NDT];
#pragma unroll
    for (int c = 0; c < NC; ++c) { lrun[c] = 0.f;
#pragma unroll
        for (int dt = 0; dt < NDT; ++dt) O[c][dt] = (f32x4){0.f, 0.f, 0.f, 0.f}; }
    const float nmb = -A.mb;
    BAR_LDS();
    ATT_WRITE(0);
    if (1 < A.T1) ATT_LOAD(1);
    BAR_LDS();
    for (int T = 0; T < A.T1; ++T) {
        const LAS bf16* Ks = (const LAS bf16*)lds + (T & 1) * TBUF; const LAS bf16* Vs = Ks + 64 * QP;
        const int k0 = 64 * T;
        if (k0 <= qw + 15) {
            const bool domask = (k0 + 63 > qw);
            bf16x8 pf[NC][2];
#pragma unroll
            for (int c = 0; c < NC; ++c) {
                f32x4 s[4];
#pragma unroll
                for (int nt = 0; nt < 4; ++nt) { s[nt] = (f32x4){nmb, nmb, nmb, nmb};
#pragma unroll
                    for (int ks = 0; ks < 2; ++ks) { const bf16x8 kf = *(const LAS bf16x8*)(Ks + (16 * nt + li) * QP + c * 64 + 32 * ks + 8 * lg); s[nt] = __builtin_amdgcn_mfma_f32_16x16x32_bf16(kf, qf[c][ks], s[nt], 0, 0, 0); } }
                if (domask) {
#pragma unroll
                    for (int nt = 0; nt < 4; ++nt)
#pragma unroll
                        for (int i = 0; i < 4; ++i) { const int kc = k0 + 16 * nt + 4 * lg + i; if (kc > qc) s[nt][i] = -1e30f; }
                }
                float lsum = 0.f;
#pragma unroll
                for (int nt = 0; nt < 4; ++nt)
#pragma unroll
                    for (int i = 0; i < 4; ++i) { const float p = __builtin_amdgcn_exp2f(s[nt][i]); s[nt][i] = p; lsum += p; }
                lrun[c] += lsum;
#pragma unroll
                for (int kp = 0; kp < 2; ++kp) { u32x4 pk; pk.x = cvtpk(s[2 * kp][0], s[2 * kp][1]); pk.y = cvtpk(s[2 * kp][2], s[2 * kp][3]); pk.z = cvtpk(s[2 * kp + 1][0], s[2 * kp + 1][1]); pk.w = cvtpk(s[2 * kp + 1][2], s[2 * kp + 1][3]); pf[c][kp] = __builtin_bit_cast(bf16x8, pk); }
            }
#pragma unroll
            for (int dt = 0; dt < NDT; ++dt)
#pragma unroll
                for (int kp = 0; kp < 2; ++kp) { const u32x2 lo = tr_read4(Vs + (32 * kp + 4 * lg + (li >> 2)) * VP + 16 * dt + 4 * (li & 3)), hi = tr_read4(Vs + (32 * kp + 16 + 4 * lg + (li >> 2)) * VP + 16 * dt + 4 * (li & 3));
                    u32x4 vv; vv.x = lo.x; vv.y = lo.y; vv.z = hi.x; vv.w = hi.y; const bf16x8 vf = __builtin_bit_cast(bf16x8, vv);
#pragma unroll
                    for (int c = 0; c < NC; ++c) O[c][dt] = __builtin_amdgcn_mfma_f32_16x16x32_bf16(vf, pf[c][kp], O[c][dt], 0, 0, 0); }
        }
        if (T + 1 < A.T1) { ATT_WRITE((T + 1) & 1); if (T + 2 < A.T1) ATT_LOAD(T + 2); }
        BAR_LDS();
    }
#undef ATT_LOAD
#undef ATT_WRITE
    float lt[NC];
#pragma unroll
    for (int c = 0; c < NC; ++c) { float l = lrun[c]; l += __shfl_xor(l, 16); l += __shfl_xor(l, 32); lt[c] = l; }
    const float i0 = 1.0f / lt[0], i1 = A.lam / lt[1]; float ssq = 0.f;
#pragma unroll
    for (int dt = 0; dt < NDT; ++dt) { O[0][dt] = O[0][dt] * i0 - O[1][dt] * i1; ssq += (O[0][dt][0] * O[0][dt][0] + O[0][dt][1] * O[0][dt][1]) + (O[0][dt][2] * O[0][dt][2] + O[0][dt][3] * O[0][dt][3]); }
    ssq += __shfl_xor(ssq, 16); ssq += __shfl_xor(ssq, 32);
    const float rs = rsqrtf(ssq * (1.0f / (float)DV) + 1e-6f) * 0.8f;
#pragma unroll
    for (int dt = 0; dt < NDT; ++dt) { const f32x4 gg = *(const f32x4*)(A.subg + 16 * dt + 4 * lg); const f32x4 o = O[0][dt] * gg * rs; u32x2 wv; wv.x = cvtpk(o[0], o[1]); wv.y = cvtpk(o[2], o[3]); *(u32x2*)(A.O + (size_t)qc * A.ldo + 16 * dt + 4 * lg) = wv; }
}

struct DilUnit { const bf16* Q; const bf16* K; const bf16* V; bf16* O; float* lse; int dil, r, n, kbeg, nk; };
__device__ __forceinline__ bf16* op_buf(unsigned char* ws, int p) { return (bf16*)(ws + (p == 0 ? WS_B : (p == 1 ? WS_XB : WS_C))); }
__device__ __forceinline__ DilUnit dil_decode(const Args& a, int i, int G) {
    const int it = blockIdx.x + i * G; const int u = it % 48, bh = it / 48;
    const int b = bh >> 4, h = bh & 15;
    int p, dil, r, n;
    if (u < 16) { p = 0; dil = 1; r = 0; n = u; } else if (u < 32) { p = 1; dil = 4; r = (u - 16) >> 2; n = (u - 16) & 3; } else { p = 2; dil = 16; r = u - 32; n = 0; }
    const bf16* qkv = (const bf16*)(a.ws + WS_A) + (size_t)b * SEQ * NQKV + 64 * h;
    DilUnit U; U.Q = qkv; U.K = qkv + 1024; U.V = qkv + 2048; U.O = op_buf(a.ws, p) + (size_t)b * SEQ * DM + 64 * h;
    U.lse = (float*)(a.ws + WS_LSE) + (size_t)p * MROWS * 16 + (size_t)b * SEQ * 16 + h; U.dil = dil; U.r = r; U.n = n; U.kbeg = n > 0 ? 128 * (n - 1) : 0; U.nk = n > 0 ? 256 : 128;
    return U;
}
template <bool PREV>
__device__ __forceinline__ void dil_compute(const LAS bf16* Ks, const LAS bf16* Vs, bf16x8 qf0, bf16x8 qf1, int w, int lg, int li, float mb, f32x4 (&O)[4], float& lsum_out) {
    constexpr int KP = 72, NS = PREV ? 9 : 8, NPAIR = PREV ? 5 : 4;
    const int st0 = PREV ? w : 0;
    f32x4 s[10];
    {
        bf16x8 kA[NS], kB[NS];
#pragma unroll
        for (int j = 0; j < NS; ++j) { const int st = st0 + j; kA[j] = *(const LAS bf16x8*)(Ks + (16 * st + li) * KP + 8 * lg); kB[j] = *(const LAS bf16x8*)(Ks + (16 * st + li) * KP + 32 + 8 * lg); }
        __builtin_amdgcn_sched_barrier(0);
        const f32x4 zc = {-mb, -mb, -mb, -mb};
#pragma unroll
        for (int j = 0; j < NS; ++j) s[j] = __builtin_amdgcn_mfma_f32_16x16x32_bf16(kA[j], qf0, zc, 0, 0, 0);
#pragma unroll
        for (int j = 0; j < NS; ++j) s[j] = __builtin_amdgcn_mfma_f32_16x16x32_bf16(kB[j], qf1, s[j], 0, 0, 0);
    }
    u32x2 vlo[NPAIR][4], vhi[NPAIR][4];
#pragma unroll
    for (int kp = 0; kp < NPAIR; ++kp) { const int sa = st0 + 2 * kp; int sb = sa + 1; if (PREV && sb > 15) sb = 15;
#pragma unroll
        for (int dt = 0; dt < 4; ++dt) { vlo[kp][dt] = tr_read4(Vs + (16 * sa + 4 * lg + (li >> 2)) * KP + 16 * dt + 4 * (li & 3)); vhi[kp][dt] = tr_read4(Vs + (16 * sb + 4 * lg + (li >> 2)) * KP + 16 * dt + 4 * (li & 3)); } }
    __builtin_amdgcn_sched_barrier(0);
    if (PREV) {
#pragma unroll
        for (int e = 0; e < 4; ++e) { if (li > 4 * lg + e) s[0][e] = -1e30f; if (4 * lg + e > li) s[8][e] = -1e30f; }
    } else {
        const int qrel = 16 * w + li;
#pragma unroll
        for (int j = 0; j < NS; ++j)
#pragma unroll
            for (int e = 0; e < 4; ++e) if (16 * j + 4 * lg + e > qrel) s[j][e] = -1e30f;
    }
    float lsum = 0.f;
#pragma unroll
    for (int j = 0; j < NS; ++j)
#pragma unroll
        for (int e = 0; e < 4; ++e) { const float p = __builtin_amdgcn_exp2f(s[j][e]); s[j][e] = p; lsum += p; }
#pragma unroll
    for (int j = NS; j < 10; ++j) s[j] = (f32x4){0.f, 0.f, 0.f, 0.f};
#pragma unroll
    for (int dt = 0; dt < 4; ++dt) O[dt] = (f32x4){0.f, 0.f, 0.f, 0.f};
#pragma unroll
    for (int kp = 0; kp < NPAIR; ++kp) {
        u32x4 pk; pk.x = cvtpk(s[2 * kp][0], s[2 * kp][1]); pk.y = cvtpk(s[2 * kp][2], s[2 * kp][3]); pk.z = cvtpk(s[2 * kp + 1][0], s[2 * kp + 1][1]); pk.w = cvtpk(s[2 * kp + 1][2], s[2 * kp + 1][3]);
        const bf16x8 pf = __builtin_bit_cast(bf16x8, pk);
#pragma unroll
        for (int dt = 0; dt < 4; ++dt) { u32x4 vv; vv.x = vlo[kp][dt].x; vv.y = vlo[kp][dt].y; vv.z = vhi[kp][dt].x; vv.w = vhi[kp][dt].y; O[dt] = __builtin_amdgcn_mfma_f32_16x16x32_bf16(__builtin_bit_cast(bf16x8, vv), pf, O[dt], 0, 0, 0); }
    }
    lsum += __shfl_xor(lsum, 16); lsum = pg8::sum_xor32(lsum);
    lsum_out = lsum;
}
__device__ __forceinline__ void dil_store(const f32x4 (&O)[4], float lsum, float mb, int lg, bf16* Orow, float* lsep) {
    const float inv = 1.0f / lsum;
#pragma unroll
    for (int dt = 0; dt < 4; ++dt) { const f32x4 o = O[dt] * inv; u32x2 wv; wv.x = cvtpk(o[0], o[1]); wv.y = cvtpk(o[2], o[3]); *(u32x2*)(Orow + 16 * dt + 4 * lg) = wv; }
    if (lg == 0) *lsep = (mb + __log2f(lsum)) * 0.6931471805599453f;
}
__device__ __forceinline__ void p7_dilated(const Args& a, LAS unsigned char* lds) {
    constexpr int KP = 72, KBYTES = 256 * KP * 2, BUF = 2 * KBYTES, NTOT = BATCH * 16 * 48;
    const int tid = opaque_tid(), lane = tid & 63, w = __builtin_amdgcn_readfirstlane(tid >> 6), lg = lane >> 4, li = lane & 15, krow = tid >> 3, c8 = tid & 7;
    const int G = gridDim.x;
    const float mb = score_bound(a.in[20], a.in[21], lane);
    const int nun = (NTOT - (int)blockIdx.x + G - 1) / G;
    u32x4 kr[4], vr[4]; bf16x8 qn[2];
    DilUnit U = dil_decode(a, 0, G);
#define DIL_LOAD() do { \
        _Pragma("unroll") for (int j = 0; j < 4; ++j) if (64 * j < U.nk) { \
            kr[j] = *(const u32x4*)(U.K + (size_t)((U.kbeg + krow + 64 * j) * U.dil + U.r) * NQKV + 8 * c8); \
            vr[j] = *(const u32x4*)(U.V + (size_t)((U.kbeg + krow + 64 * j) * U.dil + U.r) * NQKV + 8 * c8); } \
        _Pragma("unroll") for (int ks = 0; ks < 2; ++ks) qn[ks] = *(const bf16x8*)(U.Q + (size_t)((128 * U.n + 16 * w + li) * U.dil + U.r) * NQKV + 32 * ks + 8 * lg); } while (0)
#define DIL_WRITE(buf) do { LAS bf16* Ks_ = (LAS bf16*)(lds + (buf) * BUF); LAS bf16* Vs_ = (LAS bf16*)(lds + (buf) * BUF + KBYTES); \
        _Pragma("unroll") for (int j = 0; j < 4; ++j) if (64 * j < U.nk) { \
            *(LAS u32x4*)(Ks_ + (krow + 64 * j) * KP + 8 * c8) = kr[j]; *(LAS u32x4*)(Vs_ + (krow + 64 * j) * KP + 8 * c8) = vr[j]; } } while (0)
    BAR_LDS();
    if (nun > 0) { DIL_LOAD(); DIL_WRITE(0); }
    BAR_LDS();
    DilUnit C = U; bf16x8 qf0 = qn[0], qf1 = qn[1];
    for (int i = 0; i < nun; ++i) {
        const bool more = i + 1 < nun;
        if (more) { U = dil_decode(a, i + 1, G); DIL_LOAD(); }
        const LAS bf16* Ks = (const LAS bf16*)(lds + (i & 1) * BUF); const LAS bf16* Vs = (const LAS bf16*)(lds + (i & 1) * BUF + KBYTES);
        f32x4 O[4]; float lsum;
        if (C.n > 0) dil_compute<true>(Ks, Vs, qf0, qf1, w, lg, li, mb, O, lsum);
        else dil_compute<false>(Ks, Vs, qf0, qf1, w, lg, li, mb, O, lsum);
        const int tokq = (128 * C.n + 16 * w + li) * C.dil + C.r; bf16* Orow = C.O + (size_t)tokq * DM; float* lsep = C.lse + (size_t)tokq * 16;
        if (more) { DIL_WRITE((i + 1) & 1); qf0 = qn[0]; qf1 = qn[1]; C = U; }
        asm volatile("" :: "v"(qf0), "v"(qf1));
        dil_store(O, lsum, mb, lg, Orow, lsep);
        BAR_LDS();
    }
#undef DIL_LOAD
#undef DIL_WRITE
}
__device__ __forceinline__ int next_item(LAS unsigned char* lds, unsigned* ctr) {
    LAS int* slot = (LAS int*)(lds + LDS_ITEM);
    __syncthreads();
    if (threadIdx.x == 0) *slot = (int)__hip_atomic_fetch_add(ctr, 1u, __ATOMIC_RELAXED, __HIP_MEMORY_SCOPE_AGENT);
    __syncthreads();
    return *slot;
}
__device__ __forceinline__ void p2_mixers(const Args& a, LAS unsigned char* lds, int coff) {
    const int lane = opaque_tid() & 63;
    float lam; { const float d1 = wave_sum(a.in[12][lane] * a.in[13][lane]), d2 = wave_sum(a.in[14][lane] * a.in[15][lane]); lam = __expf(d1) - __expf(d2) + 0.2f; }
    unsigned* ctr = (unsigned*)(a.ws + WS_CTL) + coff;
    const float mb = score_bound(a.in[10], a.in[11], lane);
    constexpr int NATT = BATCH * 4 * 16;
#ifndef NO_RGLRU
    for (;;) {
        const int it = next_item(lds, ctr);
        if (it >= 128) break;
        rglru_unit(lds, a, it >> 3, it & 7);
    }
#if PROBE == 20
    for (;;) {
        const int it = next_item(lds, ctr + 16);
        if (it >= 128) break;
        rglru_unit(lds, a, it >> 3, it & 7);
    }
#endif
#endif
#ifndef NO_DIFF
    {
        LAS int* slot = (LAS int*)(lds + LDS_ITEM);
        int j = next_item(lds, ctr + 2);
        while (j < NATT) {
            unsigned nxt = 0u; if (threadIdx.x == 0) nxt = __hip_atomic_fetch_add(ctr + 2, 1u, __ATOMIC_RELAXED, __HIP_MEMORY_SCOPE_AGENT);
            const int qb = 15 - (j >> 6), bh = j & 63, b = bh >> 2, h = bh & 3;
            const bf16* proj = (const bf16*)(a.ws + WS_A) + (size_t)b * SEQ * NIN;
            AttnArgs A; A.Q = proj + 1024 + 128 * h; A.K = proj + 1536 + 128 * h; A.V = proj + 2048 + 128 * h; A.ld = NIN;
            A.qc0 = 128 * qb; A.T1 = 2 * qb + 2;
            A.O = (bf16*)(a.ws + WS_B) + (size_t)b * SEQ * DM + 512 + 128 * h; A.ldo = DM; A.lam = lam; A.subg = a.in[16]; A.mb = mb;
            diff_unit(lds, A);
            if (threadIdx.x == 0) *slot = (int)nxt;
            BAR_LDS();
            j = *slot;
        }
    }
#endif
}
__device__ __forceinline__ void p7b_merge(const Args& a) {
    const int gt = blockIdx.x * 512 + opaque_tid(), NGT = gridDim.x * 512;
    const float* lse = (const float*)(a.ws + WS_LSE);
    bf16* o0 = op_buf(a.ws, 0); const bf16* o1 = op_buf(a.ws, 1); const bf16* o2 = op_buf(a.ws, 2);
    for (int i = gt; i < MROWS * 16; i += NGT) {
        const int row = i >> 4, h = i & 15; const size_t off = (size_t)row * DM + 64 * h;
        const float l0 = lse[i], l1 = lse[(size_t)MROWS * 16 + i], l2 = lse[(size_t)2 * MROWS * 16 + i];
        u32x4 v0[8], v1[8], v2[8];
#pragma unroll
        for (int c = 0; c < 8; ++c) { v0[c] = *(const u32x4*)(o0 + off + 8 * c); v1[c] = *(const u32x4*)(o1 + off + 8 * c); v2[c] = *(const u32x4*)(o2 + off + 8 * c); }
        const float mx = fmaxf(l0, fmaxf(l1, l2)); float e0 = __expf(l0 - mx), e1 = __expf(l1 - mx), e2 = __expf(l2 - mx); const float inv = 1.0f / (e0 + e1 + e2); e0 *= inv; e1 *= inv; e2 *= inv;
#pragma unroll
        for (int c = 0; c < 8; ++c) { u32x4 o;
            o.x = cvtpk(e0 * bflo(v0[c].x) + e1 * bflo(v1[c].x) + e2 * bflo(v2[c].x), e0 * bfhi(v0[c].x) + e1 * bfhi(v1[c].x) + e2 * bfhi(v2[c].x));
            o.y = cvtpk(e0 * bflo(v0[c].y) + e1 * bflo(v1[c].y) + e2 * bflo(v2[c].y), e0 * bfhi(v0[c].y) + e1 * bfhi(v1[c].y) + e2 * bfhi(v2[c].y));
            o.z = cvtpk(e0 * bflo(v0[c].z) + e1 * bflo(v1[c].z) + e2 * bflo(v2[c].z), e0 * bfhi(v0[c].z) + e1 * bfhi(v1[c].z) + e2 * bfhi(v2[c].z));
            o.w = cvtpk(e0 * bflo(v0[c].w) + e1 * bflo(v1[c].w) + e2 * bflo(v2[c].w), e0 * bfhi(v0[c].w) + e1 * bfhi(v1[c].w) + e2 * bfhi(v2[c].w));
            *(u32x4*)(o0 + off + 8 * c) = o; }
    }
}

template <class Epi> __device__ __forceinline__ void run_gemm(LAS unsigned char* lds, const bf16* A, const bf16* Bt, int N, int K, const Epi& E) {
    pg8::Gemm g{A, Bt, MROWS, N, K}; pg8::StaticOrder S; S.init(MROWS, N, (int)gridDim.x, (int)blockIdx.x);
    pg8::gemm_phase<Epi, pg8::StaticOrder, true, true>(lds, g, S, E);
}
#ifndef PHMASK
#define PHMASK 0xfff
#endif
#ifndef PROBE
#define PROBE -1
#endif
#define REP(n) for (int rep = 0; rep < 1; ++rep)
#if PROBE == 30
#define GSYNC() do { xcd_barrier(xbar); xcd_barrier(xbar); } while (0)
#else
#define GSYNC() xcd_barrier(xbar)
#endif
#define DUP(n, ...) do { if ((PROBE) == (n)) { __VA_ARGS__; } } while (0)
__global__ void __launch_bounds__(512) fwd_megakernel(Args a) {
    extern __shared__ __attribute__((aligned(16))) unsigned char lds_raw[];
    LAS unsigned char* lds = (LAS unsigned char*)lds_raw;
    cg::grid_group grid = cg::this_grid();
    unsigned char* ws = a.ws;
    float* ssq = (float*)(ws + WS_SSQ); const float* ropec = (const float*)(ws + WS_ROPE);
    bf16* xb = (bf16*)(ws + WS_XB); bf16* bufA = (bf16*)(ws + WS_A); bf16* bufB = (bf16*)(ws + WS_B);
    REP(0) { p0_prologue(a, lds); } DUP(0, p0_prologue(a, lds));
    if (threadIdx.x < 2) ((LAS unsigned*)(lds + LDS_BARST))[threadIdx.x] = 0u;
    grid.sync();
    const XcdBarrier xbar = xcd_barrier_post((unsigned*)(ws + WS_CTL) + CW_BAR, (volatile LAS unsigned*)(lds + LDS_BARST));
    REP(1) { run_gemm(lds, xb, (const bf16*)(ws + WS_WIN), NIN, DM, pg8::EpiQK{bufA, NIN, ssq, 4, 6, 8, a.in[10], a.in[11], ropec, ropec + SEQ * 8, (LAS float*)(lds + 131072)}); }
    GSYNC();
    REP(2) { p2_mixers(a, lds, 0); } DUP(2, p2_mixers(a, lds, 8));
    GSYNC();
    { run_gemm(lds, bufB, (const bf16*)(ws + WS_WO0), DM, DM, pg8::EpiResid{a.in[0], a.out, xb, ssq + MROWS}); }
    DUP(3, run_gemm(lds, bufB, (const bf16*)(ws + WS_WO0), DM, DM, pg8::EpiScale{bufA, DM, ssq}));
    GSYNC();
    REP(4) { run_gemm(lds, xb, (const bf16*)(ws + WS_WGU0), 2 * DFF, DM, pg8::EpiSwiGLU{bufA, ssq + MROWS}); } DUP(4, run_gemm(lds, xb, (const bf16*)(ws + WS_WGU0), 2 * DFF, DM, pg8::EpiSwiGLU{bufA, ssq + MROWS}));
    GSYNC();
    { run_gemm(lds, bufA, (const bf16*)(ws + WS_WDN0), DM, DFF, pg8::EpiResid{a.out, a.out, xb, ssq + 2 * MROWS}); }
    DUP(5, run_gemm(lds, bufA, (const bf16*)(ws + WS_WDN0), DM, DFF, pg8::EpiScale{bufB, DM, ssq}));
    GSYNC();
    REP(6) { run_gemm(lds, xb, (const bf16*)(ws + WS_WQKV), NQKV, DM, pg8::EpiQK{bufA, NQKV, ssq + 2 * MROWS, 0, 4, 8, a.in[20], a.in[21], ropec, ropec + SEQ * 8, (LAS float*)(lds + 131072)}); }
    GSYNC();
    REP(7) { p7_dilated(a, lds); } DUP(7, p7_dilated(a, lds));
    GSYNC();
    p7b_merge(a);
    GSYNC();
    { run_gemm(lds, bufB, (const bf16*)(ws + WS_WO1), DM, DM, pg8::EpiResid{a.out, a.out, xb, ssq + 3 * MROWS}); }
    GSYNC();
    REP(10) { run_gemm(lds, xb, (const bf16*)(ws + WS_WGU1), 2 * DFF, DM, pg8::EpiSwiGLU{bufA, ssq + 3 * MROWS}); }
    GSYNC();
    { run_gemm(lds, bufA, (const bf16*)(ws + WS_WDN1), DM, DFF, pg8::EpiResid{a.out, a.out, nullptr, nullptr}); }
}

extern "C" void kernel_launch(void* const* d_in, const int* in_sizes, int n_in, void* d_out, int out_size, void* d_ws, size_t ws_size, hipStream_t stream) {
    static int grid = 0;
    if (grid == 0) {
        if (n_in != 27 || out_size != MROWS * DM || ws_size < WS_END) { fprintf(stderr, "kernel_launch: unexpected shapes (n_in %d, out %d, ws %zu)\n", n_in, out_size, ws_size); grid = -1; return; }
        int dev = 0, cus = 0, per_cu = 0;
        hipGetDevice(&dev); hipDeviceGetAttribute(&cus, hipDeviceAttributeMultiprocessorCount, dev);
        if (hipFuncSetAttribute((const void*)fwd_megakernel, hipFuncAttributeMaxDynamicSharedMemorySize, LDS_BYTES) != hipSuccess) { fprintf(stderr, "kernel_launch: hipFuncSetAttribute failed\n"); grid = -1; return; }
        if (hipOccupancyMaxActiveBlocksPerMultiprocessor(&per_cu, (const void*)fwd_megakernel, 512, LDS_BYTES) != hipSuccess || per_cu < 1) { fprintf(stderr, "kernel_launch: occupancy query failed (%d)\n", per_cu); (void)hipGetLastError(); per_cu = 1; }
        grid = cus * (per_cu > 1 ? 1 : per_cu);
        fprintf(stderr, "kernel_launch: grid %d (cus %d, per_cu %d)\n", grid, cus, per_cu);
    }
    if (grid < 0) return;
    Args a{};
    for (int i = 0; i < 27; ++i) a.in[i] = (const float*)d_in[i];
    a.out = (float*)d_out; a.ws = (unsigned char*)d_ws;
    void* args[] = {&a};
    hipError_t e = hipLaunchCooperativeKernel((const void*)fwd_megakernel, dim3(grid), dim3(512), args, LDS_BYTES, stream);
    if (e != hipSuccess) fprintf(stderr, "kernel_launch: cooperative launch failed: %s (grid %d)\n", hipGetErrorString(e), grid);
}
```

```cpp
#include <hip/hip_runtime.h>
#include <hip/hip_cooperative_groups.h>
#include <cstdio>
#include <cstdint>
namespace cg = cooperative_groups;
__device__ __forceinline__ int opaque_tid() { int t = threadIdx.x; asm volatile("" : "+v"(t)); return t; }
#define BAR_LDS() asm volatile("s_waitcnt lgkmcnt(0)\n\ts_barrier" ::: "memory")
namespace pg8 {
#define PG8_LAS __attribute__((address_space(3)))
typedef unsigned short bf16_t;
typedef short bf16x8 __attribute__((ext_vector_type(8)));
typedef float f32x4 __attribute__((ext_vector_type(4)));
typedef unsigned u32x4 __attribute__((ext_vector_type(4)));
constexpr int BM = 256, BK = 64, HALF = 128, HTB = HALF * BK * 2  , STAGE_BYTES = 8 * HTB, NXCD = 8, WGM = 4;

__host__ __device__ __forceinline__ int lds_byte(int r, int c) { const int st = (r >> 4) * 2 + (c >> 5), rr = r & 15, cc = c & 31, ob = rr * 64 + cc * 2; return st * 1024 + (ob ^ (((ob >> 9) & 1) << 5)); }
__host__ __device__ __forceinline__ void stage_rc(int b, int& R, int& C) { const int st = b / 1024, sb = b % 1024, swz = sb ^ (((sb >> 9) & 1) << 5); R = (st >> 1) * 16 + swz / 64; C = (st & 1) * 32 + (swz % 64) / 2; }
__host__ __device__ __forceinline__ int perm32(int rho) { const int n = rho >> 4, i = rho & 15; return 8 * (i >> 2) + 4 * n + (i & 3); }

struct Unit { int pm, pn; };
struct Gemm { const bf16_t* A; const bf16_t* Bt; int M, N, K; };

struct StaticOrder {
    int nM, nN, nwg, G, c;
    __host__ __device__ void init(int M, int N, int G_, int c_) { nM = M / BM; nN = N / BM; nwg = nM * nN; G = G_; c = c_; }
    __host__ __device__ bool next(int i, Unit& u) const {
        const long L = (long)i * G + c; if (L >= nwg) return false;
        int wgid = (int)L; { const int q = nwg / NXCD, r = nwg % NXCD, xcd = wgid % NXCD, off = wgid / NXCD; wgid = (xcd < r ? xcd * (q + 1) : r * (q + 1) + (xcd - r) * q) + off; }
        const int nig = WGM * nN, gid = wgid / nig, fm = gid * WGM, gsz = (nM - fm) < WGM ? (nM - fm) : WGM;
        u.pm = fm + ((wgid % nig) % gsz); u.pn = (wgid % nig) / gsz; return true;
    }
    __device__ __forceinline__ void a_ready(const Unit&) const {}
    __device__ __forceinline__ void done(const Unit&) const {}
};

__device__ __forceinline__ unsigned cvt_pk_bf16(float lo, float hi) { unsigned r; asm volatile("v_cvt_pk_bf16_f32 %0, %1, %2" : "=v"(r) : "v"(lo), "v"(hi)); return r; }
typedef float f32x2 __attribute__((ext_vector_type(2)));
__device__ __forceinline__ float sum_xor32(float x) { const unsigned u = __builtin_bit_cast(unsigned, x); auto r = __builtin_amdgcn_permlane32_swap(u, u, false, false); return __builtin_bit_cast(float, (unsigned)r[0]) + __builtin_bit_cast(float, (unsigned)r[1]); }
__device__ __forceinline__ float other_half(float x, bool upper) { const unsigned u = __builtin_bit_cast(unsigned, x); auto r = __builtin_amdgcn_permlane32_swap(u, u, false, false); return __builtin_bit_cast(float, (unsigned)(upper ? r[0] : r[1])); }
__device__ __forceinline__ float rstd_of(const float* ssq, int row) { return rsqrtf(ssq[row] * (1.0f / 1024.0f) + 1e-6f); }
typedef unsigned u32x2 __attribute__((ext_vector_type(2)));
struct EpiScale {
    static constexpr bool PERM = false, AFTER_DRAIN = false;
    bf16_t* O; int ldc; const float* ssq;
    __device__ __forceinline__ void operator()(const f32x4 (&acc)[2][2][4][2], const Unit& u, int wr, int wc, int fr, int fq) const {
        const int row0 = u.pm * BM + wr * 64 + fr, col0 = u.pn * BM + wc * 32 + 4 * fq;
#pragma unroll
        for (int ai = 0; ai < 2; ++ai)
#pragma unroll
            for (int m = 0; m < 4; ++m) { const int row = row0 + ai * HALF + m * 16; const float rs = rstd_of(ssq, row); bf16_t* rp = O + (size_t)row * ldc + col0;
#pragma unroll
                for (int bj = 0; bj < 2; ++bj)
#pragma unroll
                    for (int n = 0; n < 2; ++n) { const f32x4 v = acc[ai][bj][m][n] * rs; u32x2 w; w.x = cvt_pk_bf16(v[0], v[1]); w.y = cvt_pk_bf16(v[2], v[3]); *(u32x2*)(rp + bj * HALF + n * 16) = w; } }
    }
};
struct EpiResid {
    static constexpr bool PERM = true, AFTER_DRAIN = false;
    const float* xin; float* xout; bf16_t* xb; float* ssq_next;
    __device__ __forceinline__ void operator()(const f32x4 (&acc)[2][2][4][2], const Unit& u, int wr, int wc, int fr_in, int fq_in) const {
        int fr = fr_in, fq = fq_in; asm volatile("" : "+v"(fr), "+v"(fq));
        const int row0 = u.pm * BM + wr * 64 + fr, col0 = u.pn * BM + wc * 32 + 8 * fq;
#pragma unroll
        for (int ai = 0; ai < 2; ++ai) {
            f32x4 pre[4][2][2];
#pragma unroll
            for (int m = 0; m < 4; ++m) { const size_t off = (size_t)(row0 + ai * HALF + m * 16) * 1024 + col0;
#pragma unroll
                for (int bj = 0; bj < 2; ++bj)
#pragma unroll
                    for (int n = 0; n < 2; ++n) pre[m][bj][n] = *(const f32x4*)(xin + off + bj * HALF + 4 * n); }
#pragma unroll
            for (int m = 0; m < 4; ++m) { const int row = row0 + ai * HALF + m * 16; const size_t off = (size_t)row * 1024 + col0; float s = 0.f;
#pragma unroll
                for (int bj = 0; bj < 2; ++bj) { const size_t o2 = off + bj * HALF;
                    const f32x4 x0 = pre[m][bj][0] + acc[ai][bj][m][0], x1 = pre[m][bj][1] + acc[ai][bj][m][1];
                    *(f32x4*)(xout + o2) = x0; *(f32x4*)(xout + o2 + 4) = x1;
                    if (xb) { u32x4 w; w.x = cvt_pk_bf16(x0[0], x0[1]); w.y = cvt_pk_bf16(x0[2], x0[3]); w.z = cvt_pk_bf16(x1[0], x1[1]); w.w = cvt_pk_bf16(x1[2], x1[3]); *(u32x4*)(xb + o2) = w;
                        s += ((x0[0] * x0[0] + x0[1] * x0[1]) + (x0[2] * x0[2] + x0[3] * x0[3])) + ((x1[0] * x1[0] + x1[1] * x1[1]) + (x1[2] * x1[2] + x1[3] * x1[3])); } }
                if (xb) { s += __shfl_xor(s, 16); s = sum_xor32(s); if (fq == 0) __hip_atomic_fetch_add(ssq_next + row, s, __ATOMIC_RELAXED, __HIP_MEMORY_SCOPE_AGENT); } }
            asm volatile("" ::: "memory");
        }
    }
};
struct EpiSwiGLU {
    static constexpr bool PERM = false, AFTER_DRAIN = false;
    bf16_t* H; const float* ssq;
    __device__ __forceinline__ void operator()(const f32x4 (&acc)[2][2][4][2], const Unit& u, int wr, int wc, int fr, int fq) const {
        const int row0 = u.pm * BM + wr * 64 + fr, col0 = u.pn * HALF + wc * 32 + 4 * fq;
#pragma unroll
        for (int ai = 0; ai < 2; ++ai)
#pragma unroll
            for (int m = 0; m < 4; ++m) { const int row = row0 + ai * HALF + m * 16; const float rs = rstd_of(ssq, row); bf16_t* rp = H + (size_t)row * 2816 + col0;
#pragma unroll
                for (int n = 0; n < 2; ++n) { const f32x4 g = acc[ai][0][m][n] * rs, uu = acc[ai][1][m][n] * rs; float h[4];
#pragma unroll
                    for (int i = 0; i < 4; ++i) h[i] = g[i] * uu[i] * __builtin_amdgcn_rcpf(1.0f + __expf(-g[i]));
                    u32x2 w; w.x = cvt_pk_bf16(h[0], h[1]); w.y = cvt_pk_bf16(h[2], h[3]); *(u32x2*)(rp + n * 16) = w; } }
    }
};

struct EpiQK {
    static constexpr bool PERM = false, AFTER_DRAIN = false;
    bf16_t* O; int ldc; const float* ssq; int q_lo, q_hi, k_hi; const float* qg; const float* kg; const float* rc; const float* rsn; PG8_LAS float* X;
    __device__ __forceinline__ void operator()(const f32x4 (&acc)[2][2][4][2], const Unit& u, int wr, int wc, int fr_in, int fq_in) const {
        int fr = fr_in, fq = fq_in; asm volatile("" : "+v"(fr), "+v"(fq));
        const int row0 = u.pm * BM + wr * 64 + fr, col0 = u.pn * BM + wc * 32 + 4 * fq;
        const bool isq = (u.pn >= q_lo) && (u.pn < q_hi), isk = (u.pn >= q_hi) && (u.pn < k_hi);
        if (!(isq || isk)) {
#pragma unroll
            for (int ai = 0; ai < 2; ++ai)
#pragma unroll
                for (int m = 0; m < 4; ++m) { const int row = row0 + ai * HALF + m * 16; const float rs = rstd_of(ssq, row); bf16_t* rp = O + (size_t)row * ldc + col0;
#pragma unroll
                    for (int bj = 0; bj < 2; ++bj)
#pragma unroll
                        for (int n = 0; n < 2; ++n) { const f32x4 v = acc[ai][bj][m][n] * rs; u32x2 w; w.x = cvt_pk_bf16(v[0], v[1]); w.y = cvt_pk_bf16(v[2], v[3]); *(u32x2*)(rp + bj * HALF + n * 16) = w; } }
            return;
        }
#pragma unroll
        for (int ai = 0; ai < 2; ++ai)
#pragma unroll
            for (int m = 0; m < 4; ++m) { const int rl = ai * HALF + wr * 64 + m * 16 + fr;
#pragma unroll
                for (int bj = 0; bj < 2; ++bj) { float s = 0.f;
#pragma unroll
                    for (int n = 0; n < 2; ++n) { const f32x4 v = acc[ai][bj][m][n]; s += (v[0] * v[0] + v[1] * v[1]) + (v[2] * v[2] + v[3] * v[3]); }
                    s += __shfl_xor(s, 16); s = sum_xor32(s);
                    if (fq == 0) X[(rl * 2 + bj) * 4 + wc] = s; } }
        asm volatile("s_waitcnt lgkmcnt(0)\n\ts_barrier" ::: "memory");
        const float* g = isq ? qg : kg; const float scale = isq ? (0.125f * 1.4426950408889634f) : 1.0f;
        const f32x4 g0 = *(const f32x4*)(g + 32 * (wc & 1) + 4 * fq), g1 = *(const f32x4*)(g + 32 * (wc & 1) + 16 + 4 * fq);
        const bool rot = (wc & 1) == 0;
#pragma unroll
        for (int ai = 0; ai < 2; ++ai)
#pragma unroll
            for (int m = 0; m < 4; ++m) { const int rl = ai * HALF + wr * 64 + m * 16 + fr, row = u.pm * BM + rl; const float rs = rstd_of(ssq, row); bf16_t* rp = O + (size_t)row * ldc + col0;
                const int pos = row & 2047;
                f32x4 cv = {1.f, 1.f, 1.f, 1.f}, sv = {0.f, 0.f, 0.f, 0.f};
                if (rot) { cv = *(const f32x4*)(rc + pos * 8 + 4 * (fq & 1)); sv = *(const f32x4*)(rsn + pos * 8 + 4 * (fq & 1)); if (fq < 2) sv = -sv; }
#pragma unroll
                for (int bj = 0; bj < 2; ++bj) { const float hs = (X[(rl * 2 + bj) * 4 + wc] + X[(rl * 2 + bj) * 4 + (wc ^ 1)]) * (rs * rs);
                    const float hr = rsqrtf(hs * (1.0f / 64.0f) + 1e-6f) * rs;
                    f32x4 v0 = acc[ai][bj][m][0] * hr * g0, v1 = acc[ai][bj][m][1] * hr * g1;
                    f32x4 p; p[0] = other_half(v0[0], fq >= 2); p[1] = other_half(v0[1], fq >= 2); p[2] = other_half(v0[2], fq >= 2); p[3] = other_half(v0[3], fq >= 2);
                    v0 = v0 * cv + p * sv;
                    v0 = v0 * scale; v1 = v1 * scale;
                    u32x2 w0, w1; w0.x = cvt_pk_bf16(v0[0], v0[1]); w0.y = cvt_pk_bf16(v0[2], v0[3]); w1.x = cvt_pk_bf16(v1[0], v1[1]); w1.y = cvt_pk_bf16(v1[2], v1[3]);
                    *(u32x2*)(rp + bj * HALF) = w0; *(u32x2*)(rp + bj * HALF + 16) = w1; } }
    }
};

template <class Epi, class Sched, bool ALIGN_EPI = false, bool SP2 = false>
__device__ __forceinline__ void gemm_phase(PG8_LAS unsigned char* lds, const Gemm g, const Sched& S, const Epi& E) {
    const int tid = opaque_tid(), wid = __builtin_amdgcn_readfirstlane(tid >> 6), lane = tid & 63, wr = wid >> 2, wc = wid & 3, fr = lane & 15, fq = lane >> 4;
    const int K = g.K, nt = K / BK;
    unsigned voffA[2], voffB[2];
#pragma unroll
    for (int i = 0; i < 2; ++i) { int R, C; stage_rc(tid * 16 + i * 8192, R, C); const int Rb = Epi::PERM ? ((R & ~31) + perm32(R & 31)) : R;
        voffA[i] = (unsigned)(R * K + C) * 2u; voffB[i] = (unsigned)(Rb * K + C) * 2u; }
    const size_t kstep = (size_t)(BK * 2);
    const size_t hstep = (size_t)HALF * K * 2;
    const size_t tstep = 2 * hstep;
    const unsigned ldsw = (unsigned)wid * 1024u;
    const int aoff = lds_byte(wr * 64 + fr, fq * 8), boff = lds_byte(wc * 32 + fr, fq * 8);
#define PG8_SA(b, h) (((b) * 2 + (h)) * HTB)
#define PG8_SB(b, h) ((4 + (b) * 2 + (h)) * HTB)
#define PG8_STAGE(bufoff, gbase, voff) do { _Pragma("unroll") for (int _i = 0; _i < 2; ++_i) \
        __builtin_amdgcn_global_load_lds((const unsigned*)((const char*)(gbase) + (voff)[_i]), (PG8_LAS unsigned*)(lds + (bufoff) + ldsw + _i * 8192), 16, 0, 0); } while (0)
#define PG8_LDA(dst, b, h) do { _Pragma("unroll") for (int m = 0; m < 4; ++m) _Pragma("unroll") for (int k = 0; k < 2; ++k) dst[m][k] = *(const PG8_LAS bf16x8*)(lds + PG8_SA(b, h) + aoff + m * 2048 + k * 1024); } while (0)
#define PG8_LDB(dst, b, h) do { _Pragma("unroll") for (int n = 0; n < 2; ++n) _Pragma("unroll") for (int k = 0; k < 2; ++k) dst[n][k] = *(const PG8_LAS bf16x8*)(lds + PG8_SB(b, h) + boff + n * 2048 + k * 1024); } while (0)
#define PG8_MMA(ai, bj, At, Bt) do { __builtin_amdgcn_s_setprio(1); _Pragma("unroll") for (int m = 0; m < 4; ++m) _Pragma("unroll") for (int n = 0; n < 2; ++n) _Pragma("unroll") for (int k = 0; k < 2; ++k) \
        acc[ai][bj][m][n] = __builtin_amdgcn_mfma_f32_16x16x32_bf16(Bt[n][k], At[m][k], acc[ai][bj][m][n], 0, 0, 0); __builtin_amdgcn_s_setprio(0); } while (0)
#define PG8_WAIT_V(n) asm volatile("s_waitcnt vmcnt(" #n ")" ::: "memory")
#define PG8_WAIT_L(n) asm volatile("s_waitcnt lgkmcnt(" #n ")" ::: "memory")
#define PG8_BAR __builtin_amdgcn_s_barrier()
#define PG8_SCHED __builtin_amdgcn_sched_barrier(0)
    Unit cur, nxt; int ui = 0;
    if (!S.next(0, cur)) return;
    f32x4 acc[2][2][4][2];
#pragma unroll
    for (int a = 0; a < 2; ++a)
#pragma unroll
        for (int b = 0; b < 2; ++b)
#pragma unroll
            for (int m = 0; m < 4; ++m)
#pragma unroll
                for (int n = 0; n < 2; ++n) acc[a][b][m][n] = (f32x4){0.f, 0.f, 0.f, 0.f};
    bf16x8 At[4][2], B0[2][2], B1[2][2];
    const char* cA = (const char*)g.A + (size_t)cur.pm * tstep; const char* cB = (const char*)g.Bt + (size_t)cur.pn * tstep;
    S.a_ready(cur);
    if constexpr (SP2) {
        PG8_STAGE(PG8_SB(0, 0), cB, voffB); PG8_STAGE(PG8_SB(0, 1), cB + hstep, voffB); PG8_STAGE(PG8_SA(0, 0), cA, voffA); PG8_STAGE(PG8_SA(0, 1), cA + hstep, voffA);
        if (wr == 1) PG8_BAR;
        PG8_WAIT_V(2); PG8_BAR;
        PG8_STAGE(PG8_SB(1, 0), cB + kstep, voffB); PG8_STAGE(PG8_SA(1, 0), cA + kstep, voffA); PG8_STAGE(PG8_SB(1, 1), cB + hstep + kstep, voffB);
        PG8_WAIT_V(6); PG8_BAR;
    } else {
        PG8_STAGE(PG8_SB(0, 0), cB, voffB); PG8_STAGE(PG8_SA(0, 0), cA, voffA); PG8_STAGE(PG8_SB(0, 1), cB + hstep, voffB); PG8_STAGE(PG8_SA(0, 1), cA + hstep, voffA);
        if (wr == 1) PG8_BAR;
        PG8_WAIT_V(4); PG8_BAR;
        PG8_STAGE(PG8_SB(1, 0), cB + kstep, voffB); PG8_STAGE(PG8_SA(1, 0), cA + kstep, voffA); PG8_STAGE(PG8_SB(1, 1), cB + hstep + kstep, voffB);
        PG8_WAIT_V(6); PG8_BAR;
    }
    for (;;) {
        const bool has_next = S.next(ui + 1, nxt);
        const char* nA = has_next ? (const char*)g.A + (size_t)nxt.pm * tstep : cA; const char* nB = has_next ? (const char*)g.Bt + (size_t)nxt.pn * tstep : cB;
        for (int t = 0; t < nt; t += 2) {
            const bool last = (t == nt - 2);
            const char* a1 = cA + (size_t)(t + 1) * kstep;
            const char* a2 = last ? nA : cA + (size_t)(t + 2) * kstep; const char* b2 = last ? nB : cB + (size_t)(t + 2) * kstep;
            const char* a3 = a2 + kstep; const char* b3 = b2 + kstep;
            if (last && has_next) S.a_ready(nxt);
            if constexpr (SP2) {
            PG8_LDB(B0, 0, 0); PG8_LDB(B1, 0, 1); PG8_SCHED; PG8_LDA(At, 0, 0); PG8_STAGE(PG8_SA(1, 1), a1 + hstep, voffA);
            PG8_WAIT_V(8); PG8_WAIT_L(0); PG8_BAR; PG8_MMA(0, 0, At, B0); PG8_MMA(0, 1, At, B1); PG8_BAR; PG8_SCHED;
            PG8_LDA(At, 0, 1); PG8_STAGE(PG8_SB(0, 0), b2, voffB); PG8_STAGE(PG8_SB(0, 1), b2 + hstep, voffB); PG8_STAGE(PG8_SA(0, 0), a2, voffA);
            PG8_WAIT_V(8); PG8_WAIT_L(0); PG8_BAR; PG8_MMA(1, 0, At, B0); PG8_MMA(1, 1, At, B1); PG8_BAR; PG8_SCHED;
            PG8_LDB(B0, 1, 0); PG8_LDB(B1, 1, 1); PG8_SCHED; PG8_LDA(At, 1, 0); PG8_STAGE(PG8_SA(0, 1), a2 + hstep, voffA);
            PG8_WAIT_V(8); PG8_WAIT_L(0); PG8_BAR; PG8_MMA(0, 0, At, B0); PG8_MMA(0, 1, At, B1); PG8_BAR; PG8_SCHED;
            PG8_LDA(At, 1, 1); PG8_STAGE(PG8_SB(1, 0), b3, voffB); PG8_STAGE(PG8_SB(1, 1), b3 + hstep, voffB); PG8_STAGE(PG8_SA(1, 0), a3, voffA);
            PG8_WAIT_V(8); PG8_WAIT_L(0); PG8_BAR; PG8_MMA(1, 0, At, B0); PG8_MMA(1, 1, At, B1); PG8_BAR; PG8_SCHED;
            } else {
            PG8_LDB(B0, 0, 0); PG8_SCHED; PG8_LDA(At, 0, 0); PG8_STAGE(PG8_SA(1, 1), a1 + hstep, voffA);
            PG8_WAIT_L(8); PG8_BAR; PG8_WAIT_L(0); PG8_MMA(0, 0, At, B0); PG8_BAR; PG8_SCHED;
            PG8_LDB(B1, 0, 1); PG8_STAGE(PG8_SB(0, 0), b2, voffB);
            PG8_BAR; PG8_WAIT_L(0); PG8_MMA(0, 1, At, B1); PG8_BAR;
            PG8_LDA(At, 0, 1); PG8_STAGE(PG8_SA(0, 0), a2, voffA);
            PG8_BAR; PG8_WAIT_L(0); PG8_MMA(1, 0, At, B0); PG8_BAR; PG8_SCHED;
            PG8_STAGE(PG8_SB(0, 1), b2 + hstep, voffB);
            PG8_WAIT_V(6); PG8_BAR; PG8_MMA(1, 1, At, B1); PG8_BAR;
            PG8_LDB(B0, 1, 0); PG8_SCHED; PG8_LDA(At, 1, 0); PG8_STAGE(PG8_SA(0, 1), a2 + hstep, voffA);
            PG8_WAIT_L(8); PG8_BAR; PG8_WAIT_L(0); PG8_MMA(0, 0, At, B0); PG8_BAR; PG8_SCHED;
            PG8_LDB(B1, 1, 1); PG8_STAGE(PG8_SB(1, 0), b3, voffB);
            PG8_BAR; PG8_WAIT_L(0); PG8_MMA(0, 1, At, B1); PG8_BAR;
            PG8_LDA(At, 1, 1); PG8_STAGE(PG8_SA(1, 0), a3, voffA);
            PG8_BAR; PG8_WAIT_L(0); PG8_MMA(1, 0, At, B0); PG8_BAR; PG8_SCHED;
            PG8_STAGE(PG8_SB(1, 1), b3 + hstep, voffB);
            PG8_WAIT_V(6); PG8_BAR; PG8_MMA(1, 1, At, B1); PG8_BAR;
            }
        }
        if constexpr (ALIGN_EPI) { if (wr == 0) PG8_BAR; }
        if constexpr (!Epi::AFTER_DRAIN) { E(acc, cur, wr, wc, fr, fq); S.done(cur); }
        if (!has_next) break;
#pragma unroll
        for (int a = 0; a < 2; ++a)
#pragma unroll
            for (int b = 0; b < 2; ++b)
#pragma unroll
                for (int m = 0; m < 4; ++m)
#pragma unroll
                    for (int n = 0; n < 2; ++n) acc[a][b][m][n] = (f32x4){0.f, 0.f, 0.f, 0.f};
        cur = nxt; cA = nA; cB = nB; ++ui;
        if constexpr (ALIGN_EPI) { if (wr == 1) PG8_BAR; }
    }
    PG8_WAIT_V(0);
    if constexpr (!ALIGN_EPI) { if (wr == 0) PG8_BAR; }
    PG8_BAR;
    if constexpr (Epi::AFTER_DRAIN) { E.fused(acc, cur, wr, wc, fr, fq, lds, wid, lane); S.done(cur); }
#undef PG8_SA
#undef PG8_SB
#undef PG8_STAGE
#undef PG8_LDA
#undef PG8_LDB
#undef PG8_MMA
#undef PG8_WAIT_V
#undef PG8_WAIT_L
#undef PG8_BAR
#undef PG8_SCHED
}
}
#define LAS __attribute__((address_space(3)))
typedef unsigned short bf16;
typedef short bf16x8 __attribute__((ext_vector_type(8)));
typedef float f32x4 __attribute__((ext_vector_type(4)));
typedef unsigned u32x4 __attribute__((ext_vector_type(4)));
typedef unsigned u32x2 __attribute__((ext_vector_type(2)));
constexpr int BATCH = 16, SEQ = 2048, DM = 1024, MROWS = BATCH * SEQ, DFF = 2816, NIN = 2560, NQKV = 3072;
constexpr size_t MiB = 1u << 20;
constexpr size_t WS_CTL = 0;
constexpr size_t WS_ROPE = 1 * MiB;
constexpr size_t WS_SSQ = 2 * MiB;
constexpr size_t WS_LSE = 4 * MiB;
constexpr size_t WS_WIN = 16 * MiB, WS_WO0 = 22 * MiB, WS_WGU0 = 24 * MiB, WS_WDN0 = 36 * MiB, WS_WQKV = 42 * MiB, WS_WO1 = 48 * MiB, WS_WGU1 = 50 * MiB, WS_WDN1 = 62 * MiB;
constexpr size_t WS_XB = 68 * MiB;
constexpr size_t WS_A = 132 * MiB;
constexpr size_t WS_B = 324 * MiB;
constexpr size_t WS_C = 388 * MiB;
constexpr size_t WS_END = 452 * MiB;
constexpr int LDS_BYTES = 147456 + 256;
constexpr int LDS_ITEM = 147456;
constexpr int LDS_BARST = 147456 + 64;
constexpr int CW_BAR = 4096;

struct Args { const float* in[27]; float* out; unsigned char* ws; };

__device__ __forceinline__ unsigned cvtpk(float lo, float hi) { typedef float f2 __attribute__((ext_vector_type(2))); typedef __bf16 b2 __attribute__((ext_vector_type(2))); f2 v = {lo, hi}; b2 b = __builtin_convertvector(v, b2); return __builtin_bit_cast(unsigned, b); }
__device__ __forceinline__ float bflo(unsigned u) { return __uint_as_float(u << 16); }
__device__ __forceinline__ float bfhi(unsigned u) { return __uint_as_float(u & 0xffff0000u); }
__device__ __forceinline__ float wave_sum(float v) {
#pragma unroll
    for (int o = 1; o < 64; o <<= 1) v += __shfl_xor(v, o);
    return v;
}
#define LDS_WAIT() asm volatile("s_waitcnt lgkmcnt(0)" ::: "memory")

struct TrItem { const float* W; bf16* WT; const float* gain; int K, N, mode, r; };
__device__ __forceinline__ TrItem tr_decode(const Args& a, int it) {
    constexpr int I_IN = 32 * (NIN / 128), I_O = 32 * 8, I_G = 32 * (DFF / 128), I_D = (DFF / 32) * 8, I_Q = 32 * (NQKV / 128);
    unsigned char* ws = a.ws; int r = it; TrItem d;
    if (r < I_IN) { d = TrItem{a.in[2], (bf16*)(ws + WS_WIN), a.in[1], DM, NIN, 0, r}; return d; } r -= I_IN;
    if (r < I_O) { d = TrItem{a.in[17], (bf16*)(ws + WS_WO0), nullptr, DM, DM, 0, r}; return d; } r -= I_O;
    if (r < I_G) { d = TrItem{a.in[24], (bf16*)(ws + WS_WGU0), a.in[23], DM, DFF, 1, r}; return d; } r -= I_G;
    if (r < I_G) { d = TrItem{a.in[25], (bf16*)(ws + WS_WGU0), a.in[23], DM, DFF, 2, r}; return d; } r -= I_G;
    if (r < I_D) { d = TrItem{a.in[26], (bf16*)(ws + WS_WDN0), nullptr, DFF, DM, 0, r}; return d; } r -= I_D;
    if (r < I_Q) { d = TrItem{a.in[19], (bf16*)(ws + WS_WQKV), a.in[18], DM, NQKV, 0, r}; return d; } r -= I_Q;
    if (r < I_O) { d = TrItem{a.in[22], (bf16*)(ws + WS_WO1), nullptr, DM, DM, 0, r}; return d; } r -= I_O;
    if (r < I_G) { d = TrItem{a.in[24] + (size_t)DM * DFF, (bf16*)(ws + WS_WGU1), a.in[23] + DM, DM, DFF, 1, r}; return d; } r -= I_G;
    if (r < I_G) { d = TrItem{a.in[25] + (size_t)DM * DFF, (bf16*)(ws + WS_WGU1), a.in[23] + DM, DM, DFF, 2, r}; return d; } r -= I_G;
    d = TrItem{a.in[26] + (size_t)DFF * DM, (bf16*)(ws + WS_WDN1), nullptr, DFF, DM, 0, r}; return d;
}
__device__ __forceinline__ void tr_load(const TrItem& d, int lane, f32x4 (&v)[16]) {
    const int nblk = d.N / 128, kb = d.r / nblk, nb = d.r % nblk, k0 = 32 * kb, n0 = 128 * nb;
#pragma unroll
    for (int i = 0; i < 16; ++i) { const int kk = 2 * i + (lane >> 5); v[i] = *(const f32x4*)(d.W + (size_t)(k0 + kk) * d.N + n0 + 4 * (lane & 31)); }
}
__device__ __forceinline__ void tr_store(const TrItem& d, int lane, const f32x4 (&v)[16], LAS float* scr) {
    const int nblk = d.N / 128, kb = d.r / nblk, nb = d.r % nblk, k0 = 32 * kb, n0 = 128 * nb;
#pragma unroll
    for (int i = 0; i < 16; ++i) { const int kk = 2 * i + (lane >> 5); const float gv = d.gain ? d.gain[k0 + kk] : 1.0f; *(LAS f32x4*)(scr + kk * 132 + 4 * (lane & 31)) = v[i] * gv; }
    LDS_WAIT();
    const int rbase = (d.mode == 0) ? n0 : (256 * (n0 >> 7) + (d.mode == 2 ? 128 : 0));
#pragma unroll
    for (int h = 0; h < 2; ++h) { const int n = lane + 64 * h; const LAS float* s = scr + n; u32x4* dst = (u32x4*)(d.WT + (size_t)(rbase + n) * d.K + k0);
#pragma unroll
        for (int q = 0; q < 4; ++q) { u32x4 o; o.x = cvtpk(s[(8 * q + 0) * 132], s[(8 * q + 1) * 132]); o.y = cvtpk(s[(8 * q + 2) * 132], s[(8 * q + 3) * 132]); o.z = cvtpk(s[(8 * q + 4) * 132], s[(8 * q + 5) * 132]); o.w = cvtpk(s[(8 * q + 6) * 132], s[(8 * q + 7) * 132]); dst[q] = o; } }
    LDS_WAIT();
}
__device__ __forceinline__ void p0_prologue(const Args& a, LAS unsigned char* lds) {
    const int tid = opaque_tid(), lane = tid & 63, wave = __builtin_amdgcn_readfirstlane(tid >> 6);
    unsigned char* ws = a.ws;
    LAS float* scr = (LAS float*)(lds + wave * 17408);
    const int gw = blockIdx.x * 8 + wave, NGW = gridDim.x * 8;
    constexpr int NITEMS = 32 * (NIN / 128) + 2 * 32 * 8 + 4 * 32 * (DFF / 128) + 2 * (DFF / 32) * 8 + 32 * (NQKV / 128);
    { f32x4 va[16], vb[16];
      int it = gw; TrItem cur = tr_decode(a, it < NITEMS ? it : 0);
      if (it < NITEMS) tr_load(cur, lane, va);
      while (it < NITEMS) {
          const int i1 = it + NGW; TrItem d1 = cur; if (i1 < NITEMS) { d1 = tr_decode(a, i1); tr_load(d1, lane, vb); }
          tr_store(cur, lane, va, scr);
          if (i1 >= NITEMS) break;
          const int i2 = i1 + NGW; if (i2 < NITEMS) { cur = tr_decode(a, i2); tr_load(cur, lane, va); }
          tr_store(d1, lane, vb, scr);
          it = i2;
      } }
    const float* x = a.in[0]; bf16* xb = (bf16*)(ws + WS_XB); float* ssq = (float*)(ws + WS_SSQ);
    for (int m0 = gw * 4; m0 < MROWS; m0 += NGW * 4) {
        f32x4 v[4][4];
#pragma unroll
        for (int r = 0; r < 4; ++r)
#pragma unroll
            for (int j = 0; j < 4; ++j) v[r][j] = ((const f32x4*)(x + (size_t)(m0 + r) * DM) + lane)[64 * j];
#pragma unroll
        for (int r = 0; r < 4; ++r) { unsigned long long* o8 = (unsigned long long*)(xb + (size_t)(m0 + r) * DM) + lane; float s = 0.f;
#pragma unroll
            for (int j = 0; j < 4; ++j) { const f32x4 q = v[r][j]; s += (q[0] * q[0] + q[1] * q[1]) + (q[2] * q[2] + q[3] * q[3]); o8[64 * j] = (unsigned long long)cvtpk(q[0], q[1]) | ((unsigned long long)cvtpk(q[2], q[3]) << 32); }
            s = wave_sum(s);
            if (lane == 0) ssq[m0 + r] = s; }
    }
    const int gt = blockIdx.x * 512 + tid, NGT = gridDim.x * 512;
    for (int i = gt; i < 3 * MROWS; i += NGT) ssq[MROWS + i] = 0.f;
    for (int i = gt; i < 16384; i += NGT) ((unsigned*)(ws + WS_CTL))[i] = 0u;
    float* rc = (float*)(ws + WS_ROPE); float* rsn = rc + SEQ * 8;
    for (int i = gt; i < SEQ * 8; i += NGT) { const int pos = i >> 3, j = i & 7; const float inv = exp2f(-2.3664460711655217f * (float)j); const float ang = (float)pos * inv; double rev = (double)ang * 0.15915494309189535; rev -= rint(rev); rc[i] = __builtin_amdgcn_cosf((float)rev); rsn[i] = __builtin_amdgcn_sinf((float)rev); }
}
#define XB_TMO      128
#define XB_XCNT(j)  (256  + 64 * (j))
#define XB_XSUB(j)  (1280 + 64 * (j))
#define XB_XGEN(j)  (2304 + 64 * (j))
#define XB_TOP      3328
#define XB_TOPGEN   3392
#define XCD_BAR_WORDS 3456
#define XB_SPIN_CAP (1u << 18)

__device__ __forceinline__ unsigned xb_ld(unsigned* p)              { return __hip_atomic_load(p, __ATOMIC_RELAXED, __HIP_MEMORY_SCOPE_AGENT); }
__device__ __forceinline__ unsigned xb_add(unsigned* p, unsigned v) { return __hip_atomic_fetch_add(p, v, __ATOMIC_RELAXED, __HIP_MEMORY_SCOPE_AGENT); }
__device__ __forceinline__ unsigned xb_xcc_id() { return (unsigned)__builtin_amdgcn_s_getreg((3 << 11) | 20) & 0xFu; }
#define XB_SPIN(cond, bar) do { unsigned _sp = 0; while (cond) { __builtin_amdgcn_s_sleep(1); \
    if ((++_sp & 255u) == 0u) { if (xb_ld(&(bar)[XB_TMO])) break; if (_sp > XB_SPIN_CAP) { atomicAdd(&(bar)[XB_TMO], 1u); break; } } } } while (0)

struct XcdBarrier {
    unsigned* bar; unsigned x;
    volatile LAS unsigned* st;
};

__device__ __forceinline__ XcdBarrier xcd_barrier_post(unsigned* bar, volatile LAS unsigned* st) {
    XcdBarrier b; b.bar = bar; b.x = xb_xcc_id(); b.st = st;
    if (threadIdx.x == 0) (void)xb_add(&bar[XB_XCNT(b.x)], 1u);
    return b;
}
__device__ __forceinline__ void xcd_barrier_complete(unsigned* bar, unsigned x, unsigned& nloc, unsigned& nx) {
    const unsigned G = gridDim.x * gridDim.y * gridDim.z;
    unsigned sum, cnt, mine, sp = 0u;
    for (;;) {
        sum = 0u; cnt = 0u; mine = 0u;
#pragma unroll
        for (unsigned j = 0; j < 16; ++j) { const unsigned c = xb_ld(&bar[XB_XCNT(j)]); sum += c; cnt += (c > 0u) ? 1u : 0u; mine = (j == x) ? c : mine; }
        if (sum == G) break;
        __builtin_amdgcn_s_sleep(1);
        if ((++sp & 255u) == 0u) { if (xb_ld(&bar[XB_TMO])) break; if (sp > XB_SPIN_CAP) { atomicAdd(&bar[XB_TMO], 1u); break; } }
    }
    nloc = mine > 0u ? mine : 1u; nx = cnt > 0u ? cnt : 1u;
}

__device__ __forceinline__ void xcd_barrier(const XcdBarrier& b) {
    asm volatile("s_waitcnt vmcnt(0)" ::: "memory");
    __syncthreads();
    if (threadIdx.x == 0) {
        unsigned* bar = b.bar;
        __builtin_amdgcn_s_waitcnt(0);
        unsigned nloc = b.st[0], nx = b.st[1];
        if (nloc == 0u) { xcd_barrier_complete(bar, b.x, nloc, nx); b.st[0] = nloc; b.st[1] = nx; }
        const unsigned old = xb_add(&bar[XB_XSUB(b.x)], 1u);
        const unsigned gen = old / nloc;
        if (old + 1u == (gen + 1u) * nloc) {
            __builtin_amdgcn_fence(__ATOMIC_RELEASE, "agent");
            asm volatile("s_waitcnt vmcnt(0)" ::: "memory");
            const unsigned og = xb_add(&bar[XB_TOP], 1u);
            const unsigned tg = og / nx;
            if (og + 1u == (tg + 1u) * nx) xb_add(&bar[XB_TOPGEN], 1u);
            else XB_SPIN(xb_ld(&bar[XB_TOPGEN]) == tg, bar);
            __builtin_amdgcn_fence(__ATOMIC_ACQUIRE, "agent");
            xb_add(&bar[XB_XGEN(b.x)], 1u);
            asm volatile("s_waitcnt vmcnt(0)" ::: "memory");
        } else {
            XB_SPIN(xb_ld(&bar[XB_XGEN(b.x)]) == gen, bar);
            __builtin_amdgcn_fence(__ATOMIC_ACQUIRE, "agent");
            asm volatile("s_waitcnt vmcnt(0)" ::: "memory");
        }
    }
    __syncthreads();
}

__device__ __forceinline__ void rglru_unit(LAS unsigned char* lds, const Args& a, int b, int g) {
    const int tid = opaque_tid(), lane = tid & 63, w = __builtin_amdgcn_readfirstlane(tid >> 6), lg = lane >> 4, li = lane & 15;
    LAS bf16* Ub = (LAS bf16*)(lds);
    LAS bf16* Wat = (LAS bf16*)(lds + 18432);
    LAS bf16* Wxt = (LAS bf16*)(lds + 27648);
    constexpr int FP = 68;
    LAS float* Uf = (LAS float*)(lds + 36864);
    LAS float* Af = (LAS float*)(lds + 36864 + 34816);
    LAS float* Bf = (LAS float*)(lds + 36864 + 2 * 34816);
    LAS float* Pap = (LAS float*)(lds + 141312);
    LAS float* Phl = (LAS float*)(lds + 143360);
    LAS float* Car = (LAS float*)(lds + 145408);
    const bf16* proj = (const bf16*)(a.ws + WS_A) + (size_t)b * SEQ * NIN;
    bf16* ycat = (bf16*)(a.ws + WS_B) + (size_t)b * SEQ * DM;
    const float* wa = a.in[5] + (size_t)g * 4096; const float* wx = a.in[7] + (size_t)g * 4096;
#pragma unroll
    for (int e = 0; e < 8; ++e) { const int idx = tid + 512 * e, i = idx >> 6, j = idx & 63; Wat[j * 72 + i] = (bf16)(cvtpk(wa[idx], 0.f) & 0xffffu); Wxt[j * 72 + i] = (bf16)(cvtpk(wx[idx], 0.f) & 0xffffu); }
    if (tid < 64) Car[tid] = 0.f;
    const int c2 = tid & 31, tg = tid >> 5, ch0 = 64 * g + 2 * c2;
    float cw[4][2], cb[2];
#pragma unroll
    for (int j = 0; j < 4; ++j) { cw[j][0] = a.in[3][j * 512 + ch0]; cw[j][1] = a.in[3][j * 512 + ch0 + 1]; }
    cb[0] = a.in[4][ch0]; cb[1] = a.in[4][ch0 + 1];
    float cba[4], cbx[4], csp[4];
#pragma unroll
    for (int nt = 0; nt < 4; ++nt) { const int ch = 64 * g + 16 * nt + li; cba[nt] = a.in[6][ch]; cbx[nt] = a.in[8][ch]; const float lam = a.in[9][ch]; csp[nt] = log1pf(__expf(-lam)); }
    const int sc = lane, ss = w;
    unsigned xwr[11];
#pragma unroll
    for (int i = 0; i < 11; ++i) { const int tok = tg * 8 + i - 3; xwr[i] = tok >= 0 ? *(const unsigned*)(proj + (size_t)tok * NIN + ch0) : 0u; }
    for (int ck = 0; ck < SEQ / 128; ++ck) {
        const int s0 = ck * 128;
        BAR_LDS();
        { float xw[11][2];
#pragma unroll
          for (int i = 0; i < 11; ++i) { xw[i][0] = bflo(xwr[i]); xw[i][1] = bfhi(xwr[i]); }
          if (ck + 1 < SEQ / 128) {
#pragma unroll
              for (int i = 0; i < 11; ++i) xwr[i] = *(const unsigned*)(proj + (size_t)(s0 + 128 + tg * 8 + i - 3) * NIN + ch0); }
#pragma unroll
          for (int i = 0; i < 8; ++i) { float u0 = cb[0], u1 = cb[1];
#pragma unroll
              for (int j = 0; j < 4; ++j) { u0 += cw[j][0] * xw[i + j][0]; u1 += cw[j][1] * xw[i + j][1]; }
              const int t = tg * 8 + i; Uf[t * FP + 2 * c2] = u0; Uf[t * FP + 2 * c2 + 1] = u1; *(LAS unsigned*)(Ub + t * 72 + 2 * c2) = cvtpk(u0, u1); } }
        BAR_LDS();
        f32x4 accR[4], accI[4];
#pragma unroll
        for (int nt = 0; nt < 4; ++nt) { accR[nt] = (f32x4){0.f, 0.f, 0.f, 0.f}; accI[nt] = (f32x4){0.f, 0.f, 0.f, 0.f}; }
#pragma unroll
        for (int ks = 0; ks < 2; ++ks) { const bf16x8 af = *(const LAS bf16x8*)(Ub + (16 * w + li) * 72 + 32 * ks + 8 * lg);
#pragma unroll
            for (int nt = 0; nt < 4; ++nt) { const bf16x8 b1 = *(const LAS bf16x8*)(Wat + (16 * nt + li) * 72 + 32 * ks + 8 * lg), b2 = *(const LAS bf16x8*)(Wxt + (16 * nt + li) * 72 + 32 * ks + 8 * lg);
                accR[nt] = __builtin_amdgcn_mfma_f32_16x16x32_bf16(af, b1, accR[nt], 0, 0, 0); accI[nt] = __builtin_amdgcn_mfma_f32_16x16x32_bf16(af, b2, accI[nt], 0, 0, 0); } }
#pragma unroll
        for (int nt = 0; nt < 4; ++nt)
#pragma unroll
            for (int i = 0; i < 4; ++i) { const int t = 16 * w + 4 * lg + i, c = 16 * nt + li;
                const float r = __builtin_amdgcn_rcpf(1.0f + __expf(-(accR[nt][i] + cba[nt]))), ig = __builtin_amdgcn_rcpf(1.0f + __expf(-(accI[nt][i] + cbx[nt])));
                const float la = -8.0f * r * csp[nt]; const float av = __expf(la); const float bv = __builtin_amdgcn_sqrtf(fmaxf(fmaf(-av, av, 1.0f), 0.f)) * (ig * Uf[t * FP + c]);
                Af[t * FP + c] = av; Bf[t * FP + c] = bv; }
        unsigned short gv[16];
#pragma unroll
        for (int i = 0; i < 16; ++i) gv[i] = proj[(size_t)(s0 + 16 * ss + i) * NIN + 512 + 64 * g + sc];
        BAR_LDS();
        float hl[16], ap[16]; { float h = 0.f, p = 1.f;
#pragma unroll
          for (int i = 0; i < 16; ++i) { const float av = Af[(16 * ss + i) * FP + sc], bv = Bf[(16 * ss + i) * FP + sc]; h = av * h + bv; p *= av; hl[i] = h; ap[i] = p; }
          Pap[ss * 64 + sc] = p; Phl[ss * 64 + sc] = h; }
        BAR_LDS();
        float hin = Car[(ck & 1) * 64 + sc];
        for (int j = 0; j < ss; ++j) hin = Pap[j * 64 + sc] * hin + Phl[j * 64 + sc];
#pragma unroll
        for (int i = 0; i < 16; ++i) { const float h = hl[i] + ap[i] * hin; const float x = bflo(gv[i]); const float z = 0.7978845608028654f * (x + 0.044715f * x * x * x);
            const float ge = x * __builtin_amdgcn_rcpf(1.0f + __expf(-2.0f * z)); ycat[(size_t)(s0 + 16 * ss + i) * DM + 64 * g + sc] = (bf16)(cvtpk(h * ge, 0.f) & 0xffffu);
            if (i == 15 && ss == 7) Car[((ck + 1) & 1) * 64 + sc] = h; }
    }
    BAR_LDS();
}
typedef short v4i16_t __attribute__((ext_vector_type(4)));
__device__ __forceinline__ u32x2 tr_read4(const LAS bf16* p) { return __builtin_bit_cast(u32x2, __builtin_amdgcn_ds_read_tr16_b64_v4i16((LAS v4i16_t*)p)); }
__device__ __forceinline__ float score_bound(const float* qg, const float* kg, int lane) {
    float a = fabsf(qg[lane]), b = fabsf(kg[lane]);
#pragma unroll
    for (int o = 1; o < 64; o <<= 1) { a = fmaxf(a, __shfl_xor(a, o)); b = fmaxf(b, __shfl_xor(b, o)); }
    return 8.0f * 1.4426950408889634f * a * b * 1.01f + 0.5f;
}
struct AttnArgs {
    const bf16* Q; const bf16* K; const bf16* V; int ld;
    int qc0, T1;
    bf16* O; int ldo; float lam; const float* subg; float mb;
};
__device__ __forceinline__ void diff_unit(LAS unsigned char* lds, const AttnArgs A) {
    constexpr int NC = 2, DV = 128, QP = NC * 64 + 8, VP = DV + 16, NDT = DV / 16, NVH = DV / 64;
    const int tid = opaque_tid(), lane = tid & 63, w = __builtin_amdgcn_readfirstlane(tid >> 6), lg = lane >> 4, li = lane & 15;
    constexpr int TBUF = 64 * QP + 64 * VP;
    const int krow = tid >> 3, c8 = tid & 7;
    u32x4 kraw[NC], vraw[NVH];
#define ATT_LOAD(T) do { const int tk_ = 64 * (T) + krow; \
        _Pragma("unroll") for (int c = 0; c < NC; ++c) kraw[c] = *(const u32x4*)(A.K + (size_t)tk_ * A.ld + c * 64 + 8 * c8); \
        _Pragma("unroll") for (int hh = 0; hh < NVH; ++hh) vraw[hh] = *(const u32x4*)(A.V + (size_t)tk_ * A.ld + hh * 64 + 8 * c8); } while (0)
#define ATT_WRITE(buf) do { LAS bf16* Ks_ = (LAS bf16*)lds + (buf) * TBUF; LAS bf16* Vs_ = Ks_ + 64 * QP; \
        _Pragma("unroll") for (int c = 0; c < NC; ++c) *(LAS u32x4*)(Ks_ + krow * QP + c * 64 + 8 * c8) = kraw[c]; \
        _Pragma("unroll") for (int hh = 0; hh < NVH; ++hh) *(LAS u32x4*)(Vs_ + krow * VP + hh * 64 + 8 * c8) = vraw[hh]; } while (0)
    ATT_LOAD(0);
    const int qw = A.qc0 + 16 * w, qc = qw + li;
    bf16x8 qf[NC][2];
#pragma unroll
    for (int c = 0; c < NC; ++c)
#pragma unroll
        for (int ks = 0; ks < 2; ++ks) qf[c][ks] = *(const bf16x8*)(A.Q + (size_t)qc * A.ld + c * 64 + 32 * ks + 8 * lg);
    float lrun[NC]; f32x4 O[NC][NDT];
#pragma unroll
    for (int c = 0; c < NC; ++c) { lrun[c] = 0.f;
#pragma unroll
        for (int dt = 0; dt < NDT; ++dt) O[c][dt] = (f32x4){0.f, 0.f, 0.f, 0.f}; }
    const float nmb = -A.mb;
    BAR_LDS();
    ATT_WRITE(0);
    if (1 < A.T1) ATT_LOAD(1);
    BAR_LDS();
    for (int T = 0; T < A.T1; ++T) {
        const LAS bf16* Ks = (const LAS bf16*)lds + (T & 1) * TBUF; const LAS bf16* Vs = Ks + 64 * QP;
        const int k0 = 64 * T;
        if (k0 <= qw + 15) {
            const bool domask = (k0 + 63 > qw);
            bf16x8 pf[NC][2];
#pragma unroll
            for (int c = 0; c < NC; ++c) {
                f32x4 s[4];
#pragma unroll
                for (int nt = 0; nt < 4; ++nt) { s[nt] = (f32x4){nmb, nmb, nmb, nmb};
#pragma unroll
                    for (int ks = 0; ks < 2; ++ks) { const bf16x8 kf = *(const LAS bf16x8*)(Ks + (16 * nt + li) * QP + c * 64 + 32 * ks + 8 * lg); s[nt] = __builtin_amdgcn_mfma_f32_16x16x32_bf16(kf, qf[c][ks], s[nt], 0, 0, 0); } }
                if (domask) {
#pragma unroll
                    for (int nt = 0; nt < 4; ++nt)
#pragma unroll
                        for (int i = 0; i < 4; ++i) { const int kc = k0 + 16 * nt + 4 * lg + i; if (kc > qc) s[nt][i] = -1e30f; }
                }
                float lsum = 0.f;
#pragma unroll
                for (int nt = 0; nt < 4; ++nt)
#pragma unroll
                    for (int i = 0; i < 4; ++i) { const float p = __builtin_amdgcn_exp2f(s[nt][i]); s[nt][i] = p; lsum += p; }
                lrun[c] += lsum;
#pragma unroll
                for (int kp = 0; kp < 2; ++kp) { u32x4 pk; pk.x = cvtpk(s[2 * kp][0], s[2 * kp][1]); pk.y = cvtpk(s[2 * kp][2], s[2 * kp][3]); pk.z = cvtpk(s[2 * kp + 1][0], s[2 * kp + 1][1]); pk.w = cvtpk(s[2 * kp + 1][2], s[2 * kp + 1][3]); pf[c][kp] = __builtin_bit_cast(bf16x8, pk); }
            }
#pragma unroll
            for (int dt = 0; dt < NDT; ++dt)
#pragma unroll
                for (int kp = 0; kp < 2; ++kp) { const u32x2 lo = tr_read4(Vs + (32 * kp + 4 * lg + (li >> 2)) * VP + 16 * dt + 4 * (li & 3)), hi = tr_read4(Vs + (32 * kp + 16 + 4 * lg + (li >> 2)) * VP + 16 * dt + 4 * (li & 3));
                    u32x4 vv; vv.x = lo.x; vv.y = lo.y; vv.z = hi.x; vv.w = hi.y; const bf16x8 vf = __builtin_bit_cast(bf16x8, vv);
#pragma unroll
                    for (int c = 0; c < NC; ++c) O[c][dt] = __builtin_amdgcn_mfma_f32_16x16x32_bf16(vf, pf[c][kp], O[c][dt], 0, 0, 0); }
        }
        if (T + 1 < A.T1) { ATT_WRITE((T + 1) & 1); if (T + 2 < A.T1) ATT_LOAD(T + 2); }
        BAR_LDS();
    }
#undef ATT_LOAD
#undef ATT_WRITE
    float lt[NC];
#pragma unroll
    for (int c = 0; c < NC; ++c) { float l = lrun[c]; l += __shfl_xor(l, 16); l += __shfl_xor(l, 32); lt[c] = l; }
    const float i0 = 1.0f / lt[0], i1 = A.lam / lt[1]; float ssq = 0.f;
#pragma unroll
    for (int dt = 0; dt < NDT; ++dt) { O[0][dt] = O[0][dt] * i0 - O[1][dt] * i1; ssq += (O[0][dt][0] * O[0][dt][0] + O[0][dt][1] * O[0][dt][1]) + (O[0][dt][2] * O[0][dt][2] + O[0][dt][3] * O[0][dt][3]); }
    ssq += __shfl_xor(ssq, 16); ssq += __shfl_xor(ssq, 32);
    const float rs = rsqrtf(ssq * (1.0f / (float)DV) + 1e-6f) * 0.8f;
#pragma unroll
    for (int dt = 0; dt < NDT; ++dt) { const f32x4 gg = *(const f32x4*)(A.subg + 16 * dt + 4 * lg); const f32x4 o = O[0][dt] * gg * rs; u32x2 wv; wv.x = cvtpk(o[0], o[1]); wv.y = cvtpk(o[2], o[3]); *(u32x2*)(A.O + (size_t)qc * A.ldo + 16 * dt + 4 * lg) = wv; }
}

struct DilUnit { const bf16* Q; const bf16* K; const bf16* V; bf16* O; float* lse; int dil, r, n, kbeg, nk; };
__device__ __forceinline__ bf16* op_buf(unsigned char* ws, int p) { return (bf16*)(ws + (p == 0 ? WS_B : (p == 1 ? WS_XB : WS_C))); }
__device__ __forceinline__ DilUnit dil_decode(const Args& a, int i, int G) {
    const int it = blockIdx.x + i * G; const int u = it % 48, bh = it / 48;
    const int b = bh >> 4, h = bh & 15;
    int p, dil, r, n;
    if (u < 16) { p = 0; dil = 1; r = 0; n = u; } else if (u < 32) { p = 1; dil = 4; r = (u - 16) >> 2; n = (u - 16) & 3; } else { p = 2; dil = 16; r = u - 32; n = 0; }
    const bf16* qkv = (const bf16*)(a.ws + WS_A) + (size_t)b * SEQ * NQKV + 64 * h;
    DilUnit U; U.Q = qkv; U.K = qkv + 1024; U.V = qkv + 2048; U.O = op_buf(a.ws, p) + (size_t)b * SEQ * DM + 64 * h;
    U.lse = (float*)(a.ws + WS_LSE) + (size_t)p * MROWS * 16 + (size_t)b * SEQ * 16 + h; U.dil = dil; U.r = r; U.n = n; U.kbeg = n > 0 ? 128 * (n - 1) : 0; U.nk = n > 0 ? 256 : 128;
    return U;
}
template <bool PREV>
__device__ __forceinline__ void dil_compute(const LAS bf16* Ks, const LAS bf16* Vs, bf16x8 qf0, bf16x8 qf1, int w, int lg, int li, float mb, f32x4 (&O)[4], float& lsum_out) {
    constexpr int KP = 72, NS = PREV ? 9 : 8, NPAIR = PREV ? 5 : 4;
    const int st0 = PREV ? w : 0;
    f32x4 s[10];
    {
        bf16x8 kA[NS], kB[NS];
#pragma unroll
        for (int j = 0; j < NS; ++j) { const int st = st0 + j; kA[j] = *(const LAS bf16x8*)(Ks + (16 * st + li) * KP + 8 * lg); kB[j] = *(const LAS bf16x8*)(Ks + (16 * st + li) * KP + 32 + 8 * lg); }
        __builtin_amdgcn_sched_barrier(0);
        const f32x4 zc = {-mb, -mb, -mb, -mb};
#pragma unroll
        for (int j = 0; j < NS; ++j) s[j] = __builtin_amdgcn_mfma_f32_16x16x32_bf16(kA[j], qf0, zc, 0, 0, 0);
#pragma unroll
        for (int j = 0; j < NS; ++j) s[j] = __builtin_amdgcn_mfma_f32_16x16x32_bf16(kB[j], qf1, s[j], 0, 0, 0);
    }
    u32x2 vlo[NPAIR][4], vhi[NPAIR][4];
#pragma unroll
    for (int kp = 0; kp < NPAIR; ++kp) { const int sa = st0 + 2 * kp; int sb = sa + 1; if (PREV && sb > 15) sb = 15;
#pragma unroll
        for (int dt = 0; dt < 4; ++dt) { vlo[kp][dt] = tr_read4(Vs + (16 * sa + 4 * lg + (li >> 2)) * KP + 16 * dt + 4 * (li & 3)); vhi[kp][dt] = tr_read4(Vs + (16 * sb + 4 * lg + (li >> 2)) * KP + 16 * dt + 4 * (li & 3)); } }
    __builtin_amdgcn_sched_barrier(0);
    if (PREV) {
#pragma unroll
        for (int e = 0; e < 4; ++e) { if (li > 4 * lg + e) s[0][e] = -1e30f; if (4 * lg + e > li) s[8][e] = -1e30f; }
    } else {
        const int qrel = 16 * w + li;
#pragma unroll
        for (int j = 0; j < NS; ++j)
#pragma unroll
            for (int e = 0; e < 4; ++e) if (16 * j + 4 * lg + e > qrel) s[j][e] = -1e30f;
    }
    float lsum = 0.f;
#pragma unroll
    for (int j = 0; j < NS; ++j)
#pragma unroll
        for (int e = 0; e < 4; ++e) { const float p = __builtin_amdgcn_exp2f(s[j][e]); s[j][e] = p; lsum += p; }
#pragma unroll
    for (int j = NS; j < 10; ++j) s[j] = (f32x4){0.f, 0.f, 0.f, 0.f};
#pragma unroll
    for (int dt = 0; dt < 4; ++dt) O[dt] = (f32x4){0.f, 0.f, 0.f, 0.f};
#pragma unroll
    for (int kp = 0; kp < NPAIR; ++kp) {
        u32x4 pk; pk.x = cvtpk(s[2 * kp][0], s[2 * kp][1]); pk.y = cvtpk(s[2 * kp][2], s[2 * kp][3]); pk.z = cvtpk(s[2 * kp + 1][0], s[2 * kp + 1][1]); pk.w = cvtpk(s[2 * kp + 1][2], s[2 * kp + 1][3]);
        const bf16x8 pf = __builtin_bit_cast(bf16x8, pk);
#pragma unroll
        for (int dt = 0; dt < 4; ++dt) { u32x4 vv; vv.x = vlo[kp][dt].x; vv.y = vlo[kp][dt].y; vv.z = vhi[kp][dt].x; vv.w = vhi[kp][dt].y; O[dt] = __builtin_amdgcn_mfma_f32_16x16x32_bf16(__builtin_bit_cast(bf16x8, vv), pf, O[dt], 0, 0, 0); }
    }
    lsum += __shfl_xor(lsum, 16); lsum = pg8::sum_xor32(lsum);
    lsum_out = lsum;
}
__device__ __forceinline__ void dil_store(const f32x4 (&O)[4], float lsum, float mb, int lg, bf16* Orow, float* lsep) {
    const float inv = 1.0f / lsum;
#pragma unroll
    for (int dt = 0; dt < 4; ++dt) { const f32x4 o = O[dt] * inv; u32x2 wv; wv.x = cvtpk(o[0], o[1]); wv.y = cvtpk(o[2], o[3]); *(u32x2*)(Orow + 16 * dt + 4 * lg) = wv; }
    if (lg == 0) *lsep = (mb + __log2f(lsum)) * 0.6931471805599453f;
}
__device__ __forceinline__ void p7_dilated(const Args& a, LAS unsigned char* lds) {
    constexpr int KP = 72, KBYTES = 256 * KP * 2, BUF = 2 * KBYTES, NTOT = BATCH * 16 * 48;
    const int tid = opaque_tid(), lane = tid & 63, w = __builtin_amdgcn_readfirstlane(tid >> 6), lg = lane >> 4, li = lane & 15, krow = tid >> 3, c8 = tid & 7;
    const int G = gridDim.x;
    const float mb = score_bound(a.in[20], a.in[21], lane);
    const int nun = (NTOT - (int)blockIdx.x + G - 1) / G;
    u32x4 kr[4], vr[4]; bf16x8 qn[2];
    DilUnit U = dil_decode(a, 0, G);
#define DIL_LOAD() do { \
        _Pragma("unroll") for (int j = 0; j < 4; ++j) if (64 * j < U.nk) { \
            kr[j] = *(const u32x4*)(U.K + (size_t)((U.kbeg + krow + 64 * j) * U.dil + U.r) * NQKV + 8 * c8); \
            vr[j] = *(const u32x4*)(U.V + (size_t)((U.kbeg + krow + 64 * j) * U.dil + U.r) * NQKV + 8 * c8); } \
        _Pragma("unroll") for (int ks = 0; ks < 2; ++ks) qn[ks] = *(const bf16x8*)(U.Q + (size_t)((128 * U.n + 16 * w + li) * U.dil + U.r) * NQKV + 32 * ks + 8 * lg); } while (0)
#define DIL_WRITE(buf) do { LAS bf16* Ks_ = (LAS bf16*)(lds + (buf) * BUF); LAS bf16* Vs_ = (LAS bf16*)(lds + (buf) * BUF + KBYTES); \
        _Pragma("unroll") for (int j = 0; j < 4; ++j) if (64 * j < U.nk) { \
            *(LAS u32x4*)(Ks_ + (krow + 64 * j) * KP + 8 * c8) = kr[j]; *(LAS u32x4*)(Vs_ + (krow + 64 * j) * KP + 8 * c8) = vr[j]; } } while (0)
    BAR_LDS();
    if (nun > 0) { DIL_LOAD(); DIL_WRITE(0); }
    BAR_LDS();
    DilUnit C = U; bf16x8 qf0 = qn[0], qf1 = qn[1];
    for (int i = 0; i < nun; ++i) {
        const bool more = i + 1 < nun;
        if (more) { U = dil_decode(a, i + 1, G); DIL_LOAD(); }
        const LAS bf16* Ks = (const LAS bf16*)(lds + (i & 1) * BUF); const LAS bf16* Vs = (const LAS bf16*)(lds + (i & 1) * BUF + KBYTES);
        f32x4 O[4]; float lsum;
        if (C.n > 0) dil_compute<true>(Ks, Vs, qf0, qf1, w, lg, li, mb, O, lsum);
        else dil_compute<false>(Ks, Vs, qf0, qf1, w, lg, li, mb, O, lsum);
        const int tokq = (128 * C.n + 16 * w + li) * C.dil + C.r; bf16* Orow = C.O + (size_t)tokq * DM; float* lsep = C.lse + (size_t)tokq * 16;
        if (more) { DIL_WRITE((i + 1) & 1); qf0 = qn[0]; qf1 = qn[1]; C = U; }
        asm volatile("" :: "v"(qf0), "v"(qf1));
        dil_store(O, lsum, mb, lg, Orow, lsep);
        BAR_LDS();
    }
#undef DIL_LOAD
#undef DIL_WRITE
}
__device__ __forceinline__ int next_item(LAS unsigned char* lds, unsigned* ctr) {
    LAS int* slot = (LAS int*)(lds + LDS_ITEM);
    __syncthreads();
    if (threadIdx.x == 0) *slot = (int)__hip_atomic_fetch_add(ctr, 1u, __ATOMIC_RELAXED, __HIP_MEMORY_SCOPE_AGENT);
    __syncthreads();
    return *slot;
}
__device__ __forceinline__ void p2_mixers(const Args& a, LAS unsigned char* lds, int coff) {
    const int lane = opaque_tid() & 63;
    float lam; { const float d1 = wave_sum(a.in[12][lane] * a.in[13][lane]), d2 = wave_sum(a.in[14][lane] * a.in[15][lane]); lam = __expf(d1) - __expf(d2) + 0.2f; }
    unsigned* ctr = (unsigned*)(a.ws + WS_CTL) + coff;
    const float mb = score_bound(a.in[10], a.in[11], lane);
    constexpr int NATT = BATCH * 4 * 16;
#ifndef NO_RGLRU
    for (;;) {
        const int it = next_item(lds, ctr);
        if (it >= 128) break;
        rglru_unit(lds, a, it >> 3, it & 7);
    }
#if PROBE == 20
    for (;;) {
        const int it = next_item(lds, ctr + 16);
        if (it >= 128) break;
        rglru_unit(lds, a, it >> 3, it & 7);
    }
#endif
#endif
#ifndef NO_DIFF
    {
        LAS int* slot = (LAS int*)(lds + LDS_ITEM);
        int j = next_item(lds, ctr + 2);
        while (j < NATT) {
            unsigned nxt = 0u; if (threadIdx.x == 0) nxt = __hip_atomic_fetch_add(ctr + 2, 1u, __ATOMIC_RELAXED, __HIP_MEMORY_SCOPE_AGENT);
            const int qb = 15 - (j >> 6), bh = j & 63, b = bh >> 2, h = bh & 3;
            const bf16* proj = (const bf16*)(a.ws + WS_A) + (size_t)b * SEQ * NIN;
            AttnArgs A; A.Q = proj + 1024 + 128 * h; A.K = proj + 1536 + 128 * h; A.V = proj + 2048 + 128 * h; A.ld = NIN;
            A.qc0 = 128 * qb; A.T1 = 2 * qb + 2;
            A.O = (bf16*)(a.ws + WS_B) + (size_t)b * SEQ * DM + 512 + 128 * h; A.ldo = DM; A.lam = lam; A.subg = a.in[16]; A.mb = mb;
            diff_unit(lds, A);
            if (threadIdx.x == 0) *slot = (int)nxt;
            BAR_LDS();
            j = *slot;
        }
    }
#endif
}
__device__ __forceinline__ void p7b_merge(const Args& a) {
    const int gt = blockIdx.x * 512 + opaque_tid(), NGT = gridDim.x * 512;
    const float* lse = (const float*)(a.ws + WS_LSE);
    bf16* o0 = op_buf(a.ws, 0); const bf16* o1 = op_buf(a.ws, 1); const bf16* o2 = op_buf(a.ws, 2);
    for (int i0 = gt; i0 < MROWS * 128; i0 += 4 * NGT) {
        float l0[4], l1[4], l2[4]; u32x4 v0[4], v1[4], v2[4];
#pragma unroll
        for (int k = 0; k < 4; ++k) { const int i = i0 + k * NGT; const int row = i >> 7, hc = i & 127, h = hc >> 3; const size_t off = (size_t)row * DM + 8 * hc;
            l0[k] = lse[(size_t)row * 16 + h]; l1[k] = lse[(size_t)MROWS * 16 + (size_t)row * 16 + h]; l2[k] = lse[(size_t)2 * MROWS * 16 + (size_t)row * 16 + h];
            v0[k] = *(const u32x4*)(o0 + off); v1[k] = *(const u32x4*)(o1 + off); v2[k] = *(const u32x4*)(o2 + off); }
#pragma unroll
        for (int k = 0; k < 4; ++k) { const int i = i0 + k * NGT; const int row = i >> 7, hc = i & 127; const size_t off = (size_t)row * DM + 8 * hc;
            const float mx = fmaxf(l0[k], fmaxf(l1[k], l2[k])); float e0 = __expf(l0[k] - mx), e1 = __expf(l1[k] - mx), e2 = __expf(l2[k] - mx); const float inv = 1.0f / (e0 + e1 + e2); e0 *= inv; e1 *= inv; e2 *= inv;
            u32x4 o;
            o.x = cvtpk(e0 * bflo(v0[k].x) + e1 * bflo(v1[k].x) + e2 * bflo(v2[k].x), e0 * bfhi(v0[k].x) + e1 * bfhi(v1[k].x) + e2 * bfhi(v2[k].x));
            o.y = cvtpk(e0 * bflo(v0[k].y) + e1 * bflo(v1[k].y) + e2 * bflo(v2[k].y), e0 * bfhi(v0[k].y) + e1 * bfhi(v1[k].y) + e2 * bfhi(v2[k].y));
            o.z = cvtpk(e0 * bflo(v0[k].z) + e1 * bflo(v1[k].z) + e2 * bflo(v2[k].z), e0 * bfhi(v0[k].z) + e1 * bfhi(v1[k].z) + e2 * bfhi(v2[k].z));
            o.w = cvtpk(e0 * bflo(v0[k].w) + e1 * bflo(v1[k].w) + e2 * bflo(v2[k].w), e0 * bfhi(v0[k].w) + e1 * bfhi(v1[k].w) + e2 * bfhi(v2[k].w));
            *(u32x4*)(o0 + off) = o; }
    }
}

template <class Epi> __device__ __forceinline__ void run_gemm(LAS unsigned char* lds, const bf16* A, const bf16* Bt, int N, int K, const Epi& E) {
    pg8::Gemm g{A, Bt, MROWS, N, K}; pg8::StaticOrder S; S.init(MROWS, N, (int)gridDim.x, (int)blockIdx.x);
    pg8::gemm_phase<Epi, pg8::StaticOrder, true, true>(lds, g, S, E);
}
#ifndef PHMASK
#define PHMASK 0xfff
#endif
#ifndef PROBE
#define PROBE -1
#endif
#define REP(n) for (int rep = 0; rep < 1; ++rep)
#if PROBE == 30
#define GSYNC() do { xcd_barrier(xbar); xcd_barrier(xbar); } while (0)
#else
#define GSYNC() xcd_barrier(xbar)
#endif
#define DUP(n, ...) do { if ((PROBE) == (n)) { __VA_ARGS__; } } while (0)
__global__ void __launch_bounds__(512) fwd_megakernel(Args a) {
    extern __shared__ __attribute__((aligned(16))) unsigned char lds_raw[];
    LAS unsigned char* lds = (LAS unsigned char*)lds_raw;
    cg::grid_group grid = cg::this_grid();
    unsigned char* ws = a.ws;
    float* ssq = (float*)(ws + WS_SSQ); const float* ropec = (const float*)(ws + WS_ROPE);
    bf16* xb = (bf16*)(ws + WS_XB); bf16* bufA = (bf16*)(ws + WS_A); bf16* bufB = (bf16*)(ws + WS_B);
    REP(0) { p0_prologue(a, lds); } DUP(0, p0_prologue(a, lds));
    if (threadIdx.x < 2) ((LAS unsigned*)(lds + LDS_BARST))[threadIdx.x] = 0u;
    grid.sync();
    const XcdBarrier xbar = xcd_barrier_post((unsigned*)(ws + WS_CTL) + CW_BAR, (volatile LAS unsigned*)(lds + LDS_BARST));
    REP(1) { run_gemm(lds, xb, (const bf16*)(ws + WS_WIN), NIN, DM, pg8::EpiQK{bufA, NIN, ssq, 4, 6, 8, a.in[10], a.in[11], ropec, ropec + SEQ * 8, (LAS float*)(lds + 131072)}); }
    GSYNC();
    REP(2) { p2_mixers(a, lds, 0); } DUP(2, p2_mixers(a, lds, 8));
    GSYNC();
    { run_gemm(lds, bufB, (const bf16*)(ws + WS_WO0), DM, DM, pg8::EpiResid{a.in[0], a.out, xb, ssq + MROWS}); }
    DUP(3, run_gemm(lds, bufB, (const bf16*)(ws + WS_WO0), DM, DM, pg8::EpiScale{bufA, DM, ssq}));
    GSYNC();
    REP(4) { run_gemm(lds, xb, (const bf16*)(ws + WS_WGU0), 2 * DFF, DM, pg8::EpiSwiGLU{bufA, ssq + MROWS}); } DUP(4, run_gemm(lds, xb, (const bf16*)(ws + WS_WGU0), 2 * DFF, DM, pg8::EpiSwiGLU{bufA, ssq + MROWS}));
    GSYNC();
    { run_gemm(lds, bufA, (const bf16*)(ws + WS_WDN0), DM, DFF, pg8::EpiResid{a.out, a.out, xb, ssq + 2 * MROWS}); }
    DUP(5, run_gemm(lds, bufA, (const bf16*)(ws + WS_WDN0), DM, DFF, pg8::EpiScale{bufB, DM, ssq}));
    GSYNC();
    REP(6) { run_gemm(lds, xb, (const bf16*)(ws + WS_WQKV), NQKV, DM, pg8::EpiQK{bufA, NQKV, ssq + 2 * MROWS, 0, 4, 8, a.in[20], a.in[21], ropec, ropec + SEQ * 8, (LAS float*)(lds + 131072)}); }
    GSYNC();
    REP(7) { p7_dilated(a, lds); } DUP(7, p7_dilated(a, lds));
    GSYNC();
    p7b_merge(a);
    GSYNC();
    { run_gemm(lds, bufB, (const bf16*)(ws + WS_WO1), DM, DM, pg8::EpiResid{a.out, a.out, xb, ssq + 3 * MROWS}); }
    GSYNC();
    REP(10) { run_gemm(lds, xb, (const bf16*)(ws + WS_WGU1), 2 * DFF, DM, pg8::EpiSwiGLU{bufA, ssq + 3 * MROWS}); }
    GSYNC();
    { run_gemm(lds, bufA, (const bf16*)(ws + WS_WDN1), DM, DFF, pg8::EpiResid{a.out, a.out, nullptr, nullptr}); }
}

extern "C" void kernel_launch(void* const* d_in, const int* in_sizes, int n_in, void* d_out, int out_size, void* d_ws, size_t ws_size, hipStream_t stream) {
    static int grid = 0;
    if (grid == 0) {
        if (n_in != 27 || out_size != MROWS * DM || ws_size < WS_END) { fprintf(stderr, "kernel_launch: unexpected shapes (n_in %d, out %d, ws %zu)\n", n_in, out_size, ws_size); grid = -1; return; }
        int dev = 0, cus = 0, per_cu = 0;
        hipGetDevice(&dev); hipDeviceGetAttribute(&cus, hipDeviceAttributeMultiprocessorCount, dev);
        if (hipFuncSetAttribute((const void*)fwd_megakernel, hipFuncAttributeMaxDynamicSharedMemorySize, LDS_BYTES) != hipSuccess) { fprintf(stderr, "kernel_launch: hipFuncSetAttribute failed\n"); grid = -1; return; }
        if (hipOccupancyMaxActiveBlocksPerMultiprocessor(&per_cu, (const void*)fwd_megakernel, 512, LDS_BYTES) != hipSuccess || per_cu < 1) { fprintf(stderr, "kernel_launch: occupancy query failed (%d)\n", per_cu); (void)hipGetLastError(); per_cu = 1; }
        grid = cus * (per_cu > 1 ? 1 : per_cu);
        fprintf(stderr, "kernel_launch: grid %d (cus %d, per_cu %d)\n", grid, cus, per_cu);
    }
    if (grid < 0) return;
    Args a{};
    for (int i = 0; i < 27; ++i) a.in[i] = (const float*)d_in[i];
    a.out = (float*)d_out; a.ws = (unsigned char*)d_ws;
    void* args[] = {&a};
    hipError_t e = hipLaunchCooperativeKernel((const void*)fwd_megakernel, dim3(grid), dim3(512), args, LDS_BYTES, stream);
    if (e != hipSuccess) fprintf(stderr, "kernel_launch: cooperative launch failed: %s (grid %d)\n", hipGetErrorString(e), grid);
}
```

```cpp
#include <hip/hip_runtime.h>
#include <hip/hip_cooperative_groups.h>
#include <cstdio>
#include <cstdint>
namespace cg = cooperative_groups;
__device__ __forceinline__ int opaque_tid() { int t = threadIdx.x; asm volatile("" : "+v"(t)); return t; }
#define BAR_LDS() asm volatile("s_waitcnt lgkmcnt(0)\n\ts_barrier" ::: "memory")
namespace pg8 {
#define PG8_LAS __attribute__((address_space(3)))
typedef unsigned short bf16_t;
typedef short bf16x8 __attribute__((ext_vector_type(8)));
typedef float f32x4 __attribute__((ext_vector_type(4)));
typedef unsigned u32x4 __attribute__((ext_vector_type(4)));
constexpr int BM = 256, BK = 64, HALF = 128, HTB = HALF * BK * 2  , STAGE_BYTES = 8 * HTB, NXCD = 8, WGM = 4;

__host__ __device__ __forceinline__ int lds_byte(int r, int c) { const int st = (r >> 4) * 2 + (c >> 5), rr = r & 15, cc = c & 31, ob = rr * 64 + cc * 2; return st * 1024 + (ob ^ (((ob >> 9) & 1) << 5)); }
__host__ __device__ __forceinline__ void stage_rc(int b, int& R, int& C) { const int st = b / 1024, sb = b % 1024, swz = sb ^ (((sb >> 9) & 1) << 5); R = (st >> 1) * 16 + swz / 64; C = (st & 1) * 32 + (swz % 64) / 2; }
__host__ __device__ __forceinline__ int perm32(int rho) { const int n = rho >> 4, i = rho & 15; return 8 * (i >> 2) + 4 * n + (i & 3); }

struct Unit { int pm, pn; };
struct Gemm { const bf16_t* A; const bf16_t* Bt; int M, N, K; };

struct StaticOrder {
    int nM, nN, nwg, G, c;
    __host__ __device__ void init(int M, int N, int G_, int c_) { nM = M / BM; nN = N / BM; nwg = nM * nN; G = G_; c = c_; }
    __host__ __device__ bool next(int i, Unit& u) const {
        const long L = (long)i * G + c; if (L >= nwg) return false;
        int wgid = (int)L; { const int q = nwg / NXCD, r = nwg % NXCD, xcd = wgid % NXCD, off = wgid / NXCD; wgid = (xcd < r ? xcd * (q + 1) : r * (q + 1) + (xcd - r) * q) + off; }
        const int nig = WGM * nN, gid = wgid / nig, fm = gid * WGM, gsz = (nM - fm) < WGM ? (nM - fm) : WGM;
        u.pm = fm + ((wgid % nig) % gsz); u.pn = (wgid % nig) / gsz; return true;
    }
    __device__ __forceinline__ void a_ready(const Unit&) const {}
    __device__ __forceinline__ void done(const Unit&) const {}
};

__device__ __forceinline__ unsigned cvt_pk_bf16(float lo, float hi) { unsigned r; asm volatile("v_cvt_pk_bf16_f32 %0, %1, %2" : "=v"(r) : "v"(lo), "v"(hi)); return r; }
typedef float f32x2 __attribute__((ext_vector_type(2)));
__device__ __forceinline__ float sum_xor32(float x) { const unsigned u = __builtin_bit_cast(unsigned, x); auto r = __builtin_amdgcn_permlane32_swap(u, u, false, false); return __builtin_bit_cast(float, (unsigned)r[0]) + __builtin_bit_cast(float, (unsigned)r[1]); }
__device__ __forceinline__ float other_half(float x, bool upper) { const unsigned u = __builtin_bit_cast(unsigned, x); auto r = __builtin_amdgcn_permlane32_swap(u, u, false, false); return __builtin_bit_cast(float, (unsigned)(upper ? r[0] : r[1])); }
__device__ __forceinline__ float rstd_of(const float* ssq, int row) { return rsqrtf(ssq[row] * (1.0f / 1024.0f) + 1e-6f); }
typedef unsigned u32x2 __attribute__((ext_vector_type(2)));
struct EpiScale {
    static constexpr bool PERM = false, AFTER_DRAIN = false;
    bf16_t* O; int ldc; const float* ssq;
    __device__ __forceinline__ void operator()(const f32x4 (&acc)[2][2][4][2], const Unit& u, int wr, int wc, int fr, int fq) const {
        const int row0 = u.pm * BM + wr * 64 + fr, col0 = u.pn * BM + wc * 32 + 4 * fq;
#pragma unroll
        for (int ai = 0; ai < 2; ++ai)
#pragma unroll
            for (int m = 0; m < 4; ++m) { const int row = row0 + ai * HALF + m * 16; const float rs = rstd_of(ssq, row); bf16_t* rp = O + (size_t)row * ldc + col0;
#pragma unroll
                for (int bj = 0; bj < 2; ++bj)
#pragma unroll
                    for (int n = 0; n < 2; ++n) { const f32x4 v = acc[ai][bj][m][n] * rs; u32x2 w; w.x = cvt_pk_bf16(v[0], v[1]); w.y = cvt_pk_bf16(v[2], v[3]); *(u32x2*)(rp + bj * HALF + n * 16) = w; } }
    }
};
struct EpiResid {
    static constexpr bool PERM = true, AFTER_DRAIN = false;
    const float* xin; float* xout; bf16_t* xb; float* ssq_next;
    __device__ __forceinline__ void operator()(const f32x4 (&acc)[2][2][4][2], const Unit& u, int wr, int wc, int fr_in, int fq_in) const {
        int fr = fr_in, fq = fq_in; asm volatile("" : "+v"(fr), "+v"(fq));
        const int row0 = u.pm * BM + wr * 64 + fr, col0 = u.pn * BM + wc * 32 + 8 * fq;
#pragma unroll
        for (int ai = 0; ai < 2; ++ai) {
            f32x4 pre[4][2][2];
#pragma unroll
            for (int m = 0; m < 4; ++m) { const size_t off = (size_t)(row0 + ai * HALF + m * 16) * 1024 + col0;
#pragma unroll
                for (int bj = 0; bj < 2; ++bj)
#pragma unroll
                    for (int n = 0; n < 2; ++n) pre[m][bj][n] = *(const f32x4*)(xin + off + bj * HALF + 4 * n); }
#pragma unroll
            for (int m = 0; m < 4; ++m) { const int row = row0 + ai * HALF + m * 16; const size_t off = (size_t)row * 1024 + col0; float s = 0.f;
#pragma unroll
                for (int bj = 0; bj < 2; ++bj) { const size_t o2 = off + bj * HALF;
                    const f32x4 x0 = pre[m][bj][0] + acc[ai][bj][m][0], x1 = pre[m][bj][1] + acc[ai][bj][m][1];
                    *(f32x4*)(xout + o2) = x0; *(f32x4*)(xout + o2 + 4) = x1;
                    if (xb) { u32x4 w; w.x = cvt_pk_bf16(x0[0], x0[1]); w.y = cvt_pk_bf16(x0[2], x0[3]); w.z = cvt_pk_bf16(x1[0], x1[1]); w.w = cvt_pk_bf16(x1[2], x1[3]); *(u32x4*)(xb + o2) = w;
                        s += ((x0[0] * x0[0] + x0[1] * x0[1]) + (x0[2] * x0[2] + x0[3] * x0[3])) + ((x1[0] * x1[0] + x1[1] * x1[1]) + (x1[2] * x1[2] + x1[3] * x1[3])); } }
                if (xb) { s += __shfl_xor(s, 16); s = sum_xor32(s); if (fq == 0) __hip_atomic_fetch_add(ssq_next + row, s, __ATOMIC_RELAXED, __HIP_MEMORY_SCOPE_AGENT); } }
            asm volatile("" ::: "memory");
        }
    }
};
struct EpiSwiGLU {
    static constexpr bool PERM = true, AFTER_DRAIN = false;
    bf16_t* H; const float* ssq;
    __device__ __forceinline__ void operator()(const f32x4 (&acc)[2][2][4][2], const Unit& u, int wr, int wc, int fr, int fq) const {
        const int row0 = u.pm * BM + wr * 64 + fr, col0 = u.pn * HALF + wc * 32 + 8 * fq;
#pragma unroll
        for (int ai = 0; ai < 2; ++ai)
#pragma unroll
            for (int m = 0; m < 4; ++m) { const int row = row0 + ai * HALF + m * 16; const float rs = rstd_of(ssq, row); bf16_t* rp = H + (size_t)row * 2816 + col0;
                float h[8];
#pragma unroll
                for (int n = 0; n < 2; ++n) { const f32x4 g = acc[ai][0][m][n] * rs, uu = acc[ai][1][m][n] * rs;
#pragma unroll
                    for (int i = 0; i < 4; ++i) h[4 * n + i] = g[i] * uu[i] * __builtin_amdgcn_rcpf(1.0f + __expf(-g[i])); }
                u32x4 w; w.x = cvt_pk_bf16(h[0], h[1]); w.y = cvt_pk_bf16(h[2], h[3]); w.z = cvt_pk_bf16(h[4], h[5]); w.w = cvt_pk_bf16(h[6], h[7]); *(u32x4*)rp = w; }
    }
};

struct EpiQK {
    static constexpr bool PERM = false, AFTER_DRAIN = false;
    bf16_t* O; int ldc; const float* ssq; int q_lo, q_hi, k_hi; const float* qg; const float* kg; const float* rc; const float* rsn; PG8_LAS float* X;
    __device__ __forceinline__ void operator()(const f32x4 (&acc)[2][2][4][2], const Unit& u, int wr, int wc, int fr_in, int fq_in) const {
        int fr = fr_in, fq = fq_in; asm volatile("" : "+v"(fr), "+v"(fq));
        const int row0 = u.pm * BM + wr * 64 + fr, col0 = u.pn * BM + wc * 32 + 4 * fq;
        const bool isq = (u.pn >= q_lo) && (u.pn < q_hi), isk = (u.pn >= q_hi) && (u.pn < k_hi);
        if (!(isq || isk)) {
#pragma unroll
            for (int ai = 0; ai < 2; ++ai)
#pragma unroll
                for (int m = 0; m < 4; ++m) { const int row = row0 + ai * HALF + m * 16; const float rs = rstd_of(ssq, row); bf16_t* rp = O + (size_t)row * ldc + col0;
#pragma unroll
                    for (int bj = 0; bj < 2; ++bj)
#pragma unroll
                        for (int n = 0; n < 2; ++n) { const f32x4 v = acc[ai][bj][m][n] * rs; u32x2 w; w.x = cvt_pk_bf16(v[0], v[1]); w.y = cvt_pk_bf16(v[2], v[3]); *(u32x2*)(rp + bj * HALF + n * 16) = w; } }
            return;
        }
#pragma unroll
        for (int ai = 0; ai < 2; ++ai)
#pragma unroll
            for (int m = 0; m < 4; ++m) { const int rl = ai * HALF + wr * 64 + m * 16 + fr;
#pragma unroll
                for (int bj = 0; bj < 2; ++bj) { float s = 0.f;
#pragma unroll
                    for (int n = 0; n < 2; ++n) { const f32x4 v = acc[ai][bj][m][n]; s += (v[0] * v[0] + v[1] * v[1]) + (v[2] * v[2] + v[3] * v[3]); }
                    s += __shfl_xor(s, 16); s = sum_xor32(s);
                    if (fq == 0) X[(rl * 2 + bj) * 4 + wc] = s; } }
        asm volatile("s_waitcnt lgkmcnt(0)\n\ts_barrier" ::: "memory");
        const float* g = isq ? qg : kg; const float scale = isq ? (0.125f * 1.4426950408889634f) : 1.0f;
        const f32x4 g0 = *(const f32x4*)(g + 32 * (wc & 1) + 4 * fq), g1 = *(const f32x4*)(g + 32 * (wc & 1) + 16 + 4 * fq);
        const bool rot = (wc & 1) == 0;
#pragma unroll
        for (int ai = 0; ai < 2; ++ai)
#pragma unroll
            for (int m = 0; m < 4; ++m) { const int rl = ai * HALF + wr * 64 + m * 16 + fr, row = u.pm * BM + rl; const float rs = rstd_of(ssq, row); bf16_t* rp = O + (size_t)row * ldc + col0;
                const int pos = row & 2047;
                f32x4 cv = {1.f, 1.f, 1.f, 1.f}, sv = {0.f, 0.f, 0.f, 0.f};
                if (rot) { cv = *(const f32x4*)(rc + pos * 8 + 4 * (fq & 1)); sv = *(const f32x4*)(rsn + pos * 8 + 4 * (fq & 1)); if (fq < 2) sv = -sv; }
#pragma unroll
                for (int bj = 0; bj < 2; ++bj) { const float hs = (X[(rl * 2 + bj) * 4 + wc] + X[(rl * 2 + bj) * 4 + (wc ^ 1)]) * (rs * rs);
                    const float hr = rsqrtf(hs * (1.0f / 64.0f) + 1e-6f) * rs;
                    f32x4 v0 = acc[ai][bj][m][0] * hr * g0, v1 = acc[ai][bj][m][1] * hr * g1;
                    f32x4 p; p[0] = other_half(v0[0], fq >= 2); p[1] = other_half(v0[1], fq >= 2); p[2] = other_half(v0[2], fq >= 2); p[3] = other_half(v0[3], fq >= 2);
                    v0 = v0 * cv + p * sv;
                    v0 = v0 * scale; v1 = v1 * scale;
                    u32x2 w0, w1; w0.x = cvt_pk_bf16(v0[0], v0[1]); w0.y = cvt_pk_bf16(v0[2], v0[3]); w1.x = cvt_pk_bf16(v1[0], v1[1]); w1.y = cvt_pk_bf16(v1[2], v1[3]);
                    *(u32x2*)(rp + bj * HALF) = w0; *(u32x2*)(rp + bj * HALF + 16) = w1; } }
    }
};

template <class Epi, class Sched, bool ALIGN_EPI = false, bool SP2 = false>
__device__ __forceinline__ void gemm_phase(PG8_LAS unsigned char* lds, const Gemm g, const Sched& S, const Epi& E) {
    const int tid = opaque_tid(), wid = __builtin_amdgcn_readfirstlane(tid >> 6), lane = tid & 63, wr = wid >> 2, wc = wid & 3, fr = lane & 15, fq = lane >> 4;
    const int K = g.K, nt = K / BK;
    unsigned voffA[2], voffB[2];
#pragma unroll
    for (int i = 0; i < 2; ++i) { int R, C; stage_rc(tid * 16 + i * 8192, R, C); const int Rb = Epi::PERM ? ((R & ~31) + perm32(R & 31)) : R;
        voffA[i] = (unsigned)(R * K + C) * 2u; voffB[i] = (unsigned)(Rb * K + C) * 2u; }
    const size_t kstep = (size_t)(BK * 2);
    const size_t hstep = (size_t)HALF * K * 2;
    const size_t tstep = 2 * hstep;
    const unsigned ldsw = (unsigned)wid * 1024u;
    const int aoff = lds_byte(wr * 64 + fr, fq * 8), boff = lds_byte(wc * 32 + fr, fq * 8);
#define PG8_SA(b, h) (((b) * 2 + (h)) * HTB)
#define PG8_SB(b, h) ((4 + (b) * 2 + (h)) * HTB)
#define PG8_STAGE(bufoff, gbase, voff) do { _Pragma("unroll") for (int _i = 0; _i < 2; ++_i) \
        __builtin_amdgcn_global_load_lds((const unsigned*)((const char*)(gbase) + (voff)[_i]), (PG8_LAS unsigned*)(lds + (bufoff) + ldsw + _i * 8192), 16, 0, 0); } while (0)
#define PG8_LDA(dst, b, h) do { _Pragma("unroll") for (int m = 0; m < 4; ++m) _Pragma("unroll") for (int k = 0; k < 2; ++k) dst[m][k] = *(const PG8_LAS bf16x8*)(lds + PG8_SA(b, h) + aoff + m * 2048 + k * 1024); } while (0)
#define PG8_LDB(dst, b, h) do { _Pragma("unroll") for (int n = 0; n < 2; ++n) _Pragma("unroll") for (int k = 0; k < 2; ++k) dst[n][k] = *(const PG8_LAS bf16x8*)(lds + PG8_SB(b, h) + boff + n * 2048 + k * 1024); } while (0)
#define PG8_MMA(ai, bj, At, Bt) do { __builtin_amdgcn_s_setprio(1); _Pragma("unroll") for (int m = 0; m < 4; ++m) _Pragma("unroll") for (int n = 0; n < 2; ++n) _Pragma("unroll") for (int k = 0; k < 2; ++k) \
        acc[ai][bj][m][n] = __builtin_amdgcn_mfma_f32_16x16x32_bf16(Bt[n][k], At[m][k], acc[ai][bj][m][n], 0, 0, 0); __builtin_amdgcn_s_setprio(0); } while (0)
#define PG8_WAIT_V(n) asm volatile("s_waitcnt vmcnt(" #n ")" ::: "memory")
#define PG8_WAIT_L(n) asm volatile("s_waitcnt lgkmcnt(" #n ")" ::: "memory")
#define PG8_BAR __builtin_amdgcn_s_barrier()
#define PG8_SCHED __builtin_amdgcn_sched_barrier(0)
    Unit cur, nxt; int ui = 0;
    if (!S.next(0, cur)) return;
    f32x4 acc[2][2][4][2];
#pragma unroll
    for (int a = 0; a < 2; ++a)
#pragma unroll
        for (int b = 0; b < 2; ++b)
#pragma unroll
            for (int m = 0; m < 4; ++m)
#pragma unroll
                for (int n = 0; n < 2; ++n) acc[a][b][m][n] = (f32x4){0.f, 0.f, 0.f, 0.f};
    bf16x8 At[4][2], B0[2][2], B1[2][2];
    const char* cA = (const char*)g.A + (size_t)cur.pm * tstep; const char* cB = (const char*)g.Bt + (size_t)cur.pn * tstep;
    S.a_ready(cur);
    if constexpr (SP2) {
        PG8_STAGE(PG8_SB(0, 0), cB, voffB); PG8_STAGE(PG8_SB(0, 1), cB + hstep, voffB); PG8_STAGE(PG8_SA(0, 0), cA, voffA); PG8_STAGE(PG8_SA(0, 1), cA + hstep, voffA);
        if (wr == 1) PG8_BAR;
        PG8_WAIT_V(2); PG8_BAR;
        PG8_STAGE(PG8_SB(1, 0), cB + kstep, voffB); PG8_STAGE(PG8_SA(1, 0), cA + kstep, voffA); PG8_STAGE(PG8_SB(1, 1), cB + hstep + kstep, voffB);
        PG8_WAIT_V(6); PG8_BAR;
    } else {
        PG8_STAGE(PG8_SB(0, 0), cB, voffB); PG8_STAGE(PG8_SA(0, 0), cA, voffA); PG8_STAGE(PG8_SB(0, 1), cB + hstep, voffB); PG8_STAGE(PG8_SA(0, 1), cA + hstep, voffA);
        if (wr == 1) PG8_BAR;
        PG8_WAIT_V(4); PG8_BAR;
        PG8_STAGE(PG8_SB(1, 0), cB + kstep, voffB); PG8_STAGE(PG8_SA(1, 0), cA + kstep, voffA); PG8_STAGE(PG8_SB(1, 1), cB + hstep + kstep, voffB);
        PG8_WAIT_V(6); PG8_BAR;
    }
    for (;;) {
        const bool has_next = S.next(ui + 1, nxt);
        const char* nA = has_next ? (const char*)g.A + (size_t)nxt.pm * tstep : cA; const char* nB = has_next ? (const char*)g.Bt + (size_t)nxt.pn * tstep : cB;
        for (int t = 0; t < nt; t += 2) {
            const bool last = (t == nt - 2);
            const char* a1 = cA + (size_t)(t + 1) * kstep;
            const char* a2 = last ? nA : cA + (size_t)(t + 2) * kstep; const char* b2 = last ? nB : cB + (size_t)(t + 2) * kstep;
            const char* a3 = a2 + kstep; const char* b3 = b2 + kstep;
            if (last && has_next) S.a_ready(nxt);
            if constexpr (SP2) {
            PG8_LDB(B0, 0, 0); PG8_LDB(B1, 0, 1); PG8_SCHED; PG8_LDA(At, 0, 0); PG8_STAGE(PG8_SA(1, 1), a1 + hstep, voffA);
            PG8_WAIT_V(8); PG8_WAIT_L(0); PG8_BAR; PG8_MMA(0, 0, At, B0); PG8_MMA(0, 1, At, B1); PG8_BAR; PG8_SCHED;
            PG8_LDA(At, 0, 1); PG8_STAGE(PG8_SB(0, 0), b2, voffB); PG8_STAGE(PG8_SB(0, 1), b2 + hstep, voffB); PG8_STAGE(PG8_SA(0, 0), a2, voffA);
            PG8_WAIT_V(8); PG8_WAIT_L(0); PG8_BAR; PG8_MMA(1, 0, At, B0); PG8_MMA(1, 1, At, B1); PG8_BAR; PG8_SCHED;
            PG8_LDB(B0, 1, 0); PG8_LDB(B1, 1, 1); PG8_SCHED; PG8_LDA(At, 1, 0); PG8_STAGE(PG8_SA(0, 1), a2 + hstep, voffA);
            PG8_WAIT_V(8); PG8_WAIT_L(0); PG8_BAR; PG8_MMA(0, 0, At, B0); PG8_MMA(0, 1, At, B1); PG8_BAR; PG8_SCHED;
            PG8_LDA(At, 1, 1); PG8_STAGE(PG8_SB(1, 0), b3, voffB); PG8_STAGE(PG8_SB(1, 1), b3 + hstep, voffB); PG8_STAGE(PG8_SA(1, 0), a3, voffA);
            PG8_WAIT_V(8); PG8_WAIT_L(0); PG8_BAR; PG8_MMA(1, 0, At, B0); PG8_MMA(1, 1, At, B1); PG8_BAR; PG8_SCHED;
            } else {
            PG8_LDB(B0, 0, 0); PG8_SCHED; PG8_LDA(At, 0, 0); PG8_STAGE(PG8_SA(1, 1), a1 + hstep, voffA);
            PG8_WAIT_L(8); PG8_BAR; PG8_WAIT_L(0); PG8_MMA(0, 0, At, B0); PG8_BAR; PG8_SCHED;
            PG8_LDB(B1, 0, 1); PG8_STAGE(PG8_SB(0, 0), b2, voffB);
            PG8_BAR; PG8_WAIT_L(0); PG8_MMA(0, 1, At, B1); PG8_BAR;
            PG8_LDA(At, 0, 1); PG8_STAGE(PG8_SA(0, 0), a2, voffA);
            PG8_BAR; PG8_WAIT_L(0); PG8_MMA(1, 0, At, B0); PG8_BAR; PG8_SCHED;
            PG8_STAGE(PG8_SB(0, 1), b2 + hstep, voffB);
            PG8_WAIT_V(6); PG8_BAR; PG8_MMA(1, 1, At, B1); PG8_BAR;
            PG8_LDB(B0, 1, 0); PG8_SCHED; PG8_LDA(At, 1, 0); PG8_STAGE(PG8_SA(0, 1), a2 + hstep, voffA);
            PG8_WAIT_L(8); PG8_BAR; PG8_WAIT_L(0); PG8_MMA(0, 0, At, B0); PG8_BAR; PG8_SCHED;
            PG8_LDB(B1, 1, 1); PG8_STAGE(PG8_SB(1, 0), b3, voffB);
            PG8_BAR; PG8_WAIT_L(0); PG8_MMA(0, 1, At, B1); PG8_BAR;
            PG8_LDA(At, 1, 1); PG8_STAGE(PG8_SA(1, 0), a3, voffA);
            PG8_BAR; PG8_WAIT_L(0); PG8_MMA(1, 0, At, B0); PG8_BAR; PG8_SCHED;
            PG8_STAGE(PG8_SB(1, 1), b3 + hstep, voffB);
            PG8_WAIT_V(6); PG8_BAR; PG8_MMA(1, 1, At, B1); PG8_BAR;
            }
        }
        if constexpr (ALIGN_EPI) { if (wr == 0) PG8_BAR; }
        if constexpr (!Epi::AFTER_DRAIN) { E(acc, cur, wr, wc, fr, fq); S.done(cur); }
        if (!has_next) break;
#pragma unroll
        for (int a = 0; a < 2; ++a)
#pragma unroll
            for (int b = 0; b < 2; ++b)
#pragma unroll
                for (int m = 0; m < 4; ++m)
#pragma unroll
                    for (int n = 0; n < 2; ++n) acc[a][b][m][n] = (f32x4){0.f, 0.f, 0.f, 0.f};
        cur = nxt; cA = nA; cB = nB; ++ui;
        if constexpr (ALIGN_EPI) { if (wr == 1) PG8_BAR; }
    }
    PG8_WAIT_V(0);
    if constexpr (!ALIGN_EPI) { if (wr == 0) PG8_BAR; }
    PG8_BAR;
    if constexpr (Epi::AFTER_DRAIN) { E.fused(acc, cur, wr, wc, fr, fq, lds, wid, lane); S.done(cur); }
#undef PG8_SA
#undef PG8_SB
#undef PG8_STAGE
#undef PG8_LDA
#undef PG8_LDB
#undef PG8_MMA
#undef PG8_WAIT_V
#undef PG8_WAIT_L
#undef PG8_BAR
#undef PG8_SCHED
}
}
#define LAS __attribute__((address_space(3)))
typedef unsigned short bf16;
typedef short bf16x8 __attribute__((ext_vector_type(8)));
typedef float f32x4 __attribute__((ext_vector_type(4)));
typedef unsigned u32x4 __attribute__((ext_vector_type(4)));
typedef unsigned u32x2 __attribute__((ext_vector_type(2)));
constexpr int BATCH = 16, SEQ = 2048, DM = 1024, MROWS = BATCH * SEQ, DFF = 2816, NIN = 2560, NQKV = 3072;
constexpr size_t MiB = 1u << 20;
constexpr size_t WS_CTL = 0;
constexpr size_t WS_ROPE = 1 * MiB;
constexpr size_t WS_SSQ = 2 * MiB;
constexpr size_t WS_LSE = 4 * MiB;
constexpr size_t WS_WIN = 16 * MiB, WS_WO0 = 22 * MiB, WS_WGU0 = 24 * MiB, WS_WDN0 = 36 * MiB, WS_WQKV = 42 * MiB, WS_WO1 = 48 * MiB, WS_WGU1 = 50 * MiB, WS_WDN1 = 62 * MiB;
constexpr size_t WS_XB = 68 * MiB;
constexpr size_t WS_A = 132 * MiB;
constexpr size_t WS_B = 324 * MiB;
constexpr size_t WS_C = 388 * MiB;
constexpr size_t WS_END = 452 * MiB;
constexpr int LDS_BYTES = 147456 + 256;
constexpr int LDS_ITEM = 147456;
constexpr int LDS_BARST = 147456 + 64;
constexpr int CW_BAR = 4096;

struct Args { const float* in[27]; float* out; unsigned char* ws; };

__device__ __forceinline__ unsigned cvtpk(float lo, float hi) { typedef float f2 __attribute__((ext_vector_type(2))); typedef __bf16 b2 __attribute__((ext_vector_type(2))); f2 v = {lo, hi}; b2 b = __builtin_convertvector(v, b2); return __builtin_bit_cast(unsigned, b); }
__device__ __forceinline__ float bflo(unsigned u) { return __uint_as_float(u << 16); }
__device__ __forceinline__ float bfhi(unsigned u) { return __uint_as_float(u & 0xffff0000u); }
__device__ __forceinline__ float wave_sum(float v) {
#pragma unroll
    for (int o = 1; o < 64; o <<= 1) v += __shfl_xor(v, o);
    return v;
}
#define LDS_WAIT() asm volatile("s_waitcnt lgkmcnt(0)" ::: "memory")

struct TrItem { const float* W; bf16* WT; const float* gain; int K, N, mode, r; };
__device__ __forceinline__ TrItem tr_decode(const Args& a, int it) {
    constexpr int I_IN = 32 * (NIN / 128), I_O = 32 * 8, I_G = 32 * (DFF / 128), I_D = (DFF / 32) * 8, I_Q = 32 * (NQKV / 128);
    unsigned char* ws = a.ws; int r = it; TrItem d;
    if (r < I_IN) { d = TrItem{a.in[2], (bf16*)(ws + WS_WIN), a.in[1], DM, NIN, 0, r}; return d; } r -= I_IN;
    if (r < I_O) { d = TrItem{a.in[17], (bf16*)(ws + WS_WO0), nullptr, DM, DM, 0, r}; return d; } r -= I_O;
    if (r < I_G) { d = TrItem{a.in[24], (bf16*)(ws + WS_WGU0), a.in[23], DM, DFF, 1, r}; return d; } r -= I_G;
    if (r < I_G) { d = TrItem{a.in[25], (bf16*)(ws + WS_WGU0), a.in[23], DM, DFF, 2, r}; return d; } r -= I_G;
    if (r < I_D) { d = TrItem{a.in[26], (bf16*)(ws + WS_WDN0), nullptr, DFF, DM, 0, r}; return d; } r -= I_D;
    if (r < I_Q) { d = TrItem{a.in[19], (bf16*)(ws + WS_WQKV), a.in[18], DM, NQKV, 0, r}; return d; } r -= I_Q;
    if (r < I_O) { d = TrItem{a.in[22], (bf16*)(ws + WS_WO1), nullptr, DM, DM, 0, r}; return d; } r -= I_O;
    if (r < I_G) { d = TrItem{a.in[24] + (size_t)DM * DFF, (bf16*)(ws + WS_WGU1), a.in[23] + DM, DM, DFF, 1, r}; return d; } r -= I_G;
    if (r < I_G) { d = TrItem{a.in[25] + (size_t)DM * DFF, (bf16*)(ws + WS_WGU1), a.in[23] + DM, DM, DFF, 2, r}; return d; } r -= I_G;
    d = TrItem{a.in[26] + (size_t)DFF * DM, (bf16*)(ws + WS_WDN1), nullptr, DFF, DM, 0, r}; return d;
}
__device__ __forceinline__ void tr_load(const TrItem& d, int lane, f32x4 (&v)[16]) {
    const int nblk = d.N / 128, kb = d.r / nblk, nb = d.r % nblk, k0 = 32 * kb, n0 = 128 * nb;
#pragma unroll
    for (int i = 0; i < 16; ++i) { const int kk = 2 * i + (lane >> 5); v[i] = *(const f32x4*)(d.W + (size_t)(k0 + kk) * d.N + n0 + 4 * (lane & 31)); }
}
__device__ __forceinline__ void tr_store(const TrItem& d, int lane, const f32x4 (&v)[16], LAS float* scr) {
    const int nblk = d.N / 128, kb = d.r / nblk, nb = d.r % nblk, k0 = 32 * kb, n0 = 128 * nb;
#pragma unroll
    for (int i = 0; i < 16; ++i) { const int kk = 2 * i + (lane >> 5); const float gv = d.gain ? d.gain[k0 + kk] : 1.0f; *(LAS f32x4*)(scr + kk * 132 + 4 * (lane & 31)) = v[i] * gv; }
    LDS_WAIT();
    const int rbase = (d.mode == 0) ? n0 : (256 * (n0 >> 7) + (d.mode == 2 ? 128 : 0));
#pragma unroll
    for (int h = 0; h < 2; ++h) { const int n = lane + 64 * h; const LAS float* s = scr + n; u32x4* dst = (u32x4*)(d.WT + (size_t)(rbase + n) * d.K + k0);
#pragma unroll
        for (int q = 0; q < 4; ++q) { u32x4 o; o.x = cvtpk(s[(8 * q + 0) * 132], s[(8 * q + 1) * 132]); o.y = cvtpk(s[(8 * q + 2) * 132], s[(8 * q + 3) * 132]); o.z = cvtpk(s[(8 * q + 4) * 132], s[(8 * q + 5) * 132]); o.w = cvtpk(s[(8 * q + 6) * 132], s[(8 * q + 7) * 132]); dst[q] = o; } }
    LDS_WAIT();
}
__device__ __forceinline__ void p0_prologue(const Args& a, LAS unsigned char* lds) {
    const int tid = opaque_tid(), lane = tid & 63, wave = __builtin_amdgcn_readfirstlane(tid >> 6);
    unsigned char* ws = a.ws;
    LAS float* scr = (LAS float*)(lds + wave * 17408);
    const int gw = blockIdx.x * 8 + wave, NGW = gridDim.x * 8;
    constexpr int NITEMS = 32 * (NIN / 128) + 2 * 32 * 8 + 4 * 32 * (DFF / 128) + 2 * (DFF / 32) * 8 + 32 * (NQKV / 128);
    { f32x4 va[16], vb[16];
      int it = gw; TrItem cur = tr_decode(a, it < NITEMS ? it : 0);
      if (it < NITEMS) tr_load(cur, lane, va);
      while (it < NITEMS) {
          const int i1 = it + NGW; TrItem d1 = cur; if (i1 < NITEMS) { d1 = tr_decode(a, i1); tr_load(d1, lane, vb); }
          tr_store(cur, lane, va, scr);
          if (i1 >= NITEMS) break;
          const int i2 = i1 + NGW; if (i2 < NITEMS) { cur = tr_decode(a, i2); tr_load(cur, lane, va); }
          tr_store(d1, lane, vb, scr);
          it = i2;
      } }
    const float* x = a.in[0]; bf16* xb = (bf16*)(ws + WS_XB); float* ssq = (float*)(ws + WS_SSQ);
    for (int m0 = gw * 4; m0 < MROWS; m0 += NGW * 4) {
        f32x4 v[4][4];
#pragma unroll
        for (int r = 0; r < 4; ++r)
#pragma unroll
            for (int j = 0; j < 4; ++j) v[r][j] = ((const f32x4*)(x + (size_t)(m0 + r) * DM) + lane)[64 * j];
#pragma unroll
        for (int r = 0; r < 4; ++r) { unsigned long long* o8 = (unsigned long long*)(xb + (size_t)(m0 + r) * DM) + lane; float s = 0.f;
#pragma unroll
            for (int j = 0; j < 4; ++j) { const f32x4 q = v[r][j]; s += (q[0] * q[0] + q[1] * q[1]) + (q[2] * q[2] + q[3] * q[3]); o8[64 * j] = (unsigned long long)cvtpk(q[0], q[1]) | ((unsigned long long)cvtpk(q[2], q[3]) << 32); }
            s = wave_sum(s);
            if (lane == 0) ssq[m0 + r] = s; }
    }
    const int gt = blockIdx.x * 512 + tid, NGT = gridDim.x * 512;
    for (int i = gt; i < 3 * MROWS; i += NGT) ssq[MROWS + i] = 0.f;
    for (int i = gt; i < 16384; i += NGT) ((unsigned*)(ws + WS_CTL))[i] = 0u;
    float* rc = (float*)(ws + WS_ROPE); float* rsn = rc + SEQ * 8;
    for (int i = gt; i < SEQ * 8; i += NGT) { const int pos = i >> 3, j = i & 7; const float inv = exp2f(-2.3664460711655217f * (float)j); const float ang = (float)pos * inv; double rev = (double)ang * 0.15915494309189535; rev -= rint(rev); rc[i] = __builtin_amdgcn_cosf((float)rev); rsn[i] = __builtin_amdgcn_sinf((float)rev); }
}
#define XB_TMO      128
#define XB_XCNT(j)  (256  + 64 * (j))
#define XB_XSUB(j)  (1280 + 64 * (j))
#define XB_XGEN(j)  (2304 + 64 * (j))
#define XB_TOP      3328
#define XB_TOPGEN   3392
#define XCD_BAR_WORDS 3456
#define XB_SPIN_CAP (1u << 18)

__device__ __forceinline__ unsigned xb_ld(unsigned* p)              { return __hip_atomic_load(p, __ATOMIC_RELAXED, __HIP_MEMORY_SCOPE_AGENT); }
__device__ __forceinline__ unsigned xb_add(unsigned* p, unsigned v) { return __hip_atomic_fetch_add(p, v, __ATOMIC_RELAXED, __HIP_MEMORY_SCOPE_AGENT); }
__device__ __forceinline__ unsigned xb_xcc_id() { return (unsigned)__builtin_amdgcn_s_getreg((3 << 11) | 20) & 0xFu; }
#define XB_SPIN(cond, bar) do { unsigned _sp = 0; while (cond) { __builtin_amdgcn_s_sleep(1); \
    if ((++_sp & 255u) == 0u) { if (xb_ld(&(bar)[XB_TMO])) break; if (_sp > XB_SPIN_CAP) { atomicAdd(&(bar)[XB_TMO], 1u); break; } } } } while (0)

struct XcdBarrier {
    unsigned* bar; unsigned x;
    volatile LAS unsigned* st;
};

__device__ __forceinline__ XcdBarrier xcd_barrier_post(unsigned* bar, volatile LAS unsigned* st) {
    XcdBarrier b; b.bar = bar; b.x = xb_xcc_id(); b.st = st;
    if (threadIdx.x == 0) (void)xb_add(&bar[XB_XCNT(b.x)], 1u);
    return b;
}
__device__ __forceinline__ void xcd_barrier_complete(unsigned* bar, unsigned x, unsigned& nloc, unsigned& nx) {
    const unsigned G = gridDim.x * gridDim.y * gridDim.z;
    unsigned sum, cnt, mine, sp = 0u;
    for (;;) {
        sum = 0u; cnt = 0u; mine = 0u;
#pragma unroll
        for (unsigned j = 0; j < 16; ++j) { const unsigned c = xb_ld(&bar[XB_XCNT(j)]); sum += c; cnt += (c > 0u) ? 1u : 0u; mine = (j == x) ? c : mine; }
        if (sum == G) break;
        __builtin_amdgcn_s_sleep(1);
        if ((++sp & 255u) == 0u) { if (xb_ld(&bar[XB_TMO])) break; if (sp > XB_SPIN_CAP) { atomicAdd(&bar[XB_TMO], 1u); break; } }
    }
    nloc = mine > 0u ? mine : 1u; nx = cnt > 0u ? cnt : 1u;
}

__device__ __forceinline__ void xcd_barrier(const XcdBarrier& b) {
    asm volatile("s_waitcnt vmcnt(0)" ::: "memory");
    __syncthreads();
    if (threadIdx.x == 0) {
        unsigned* bar = b.bar;
        __builtin_amdgcn_s_waitcnt(0);
        unsigned nloc = b.st[0], nx = b.st[1];
        if (nloc == 0u) { xcd_barrier_complete(bar, b.x, nloc, nx); b.st[0] = nloc; b.st[1] = nx; }
        const unsigned old = xb_add(&bar[XB_XSUB(b.x)], 1u);
        const unsigned gen = old / nloc;
        if (old + 1u == (gen + 1u) * nloc) {
            __builtin_amdgcn_fence(__ATOMIC_RELEASE, "agent");
            asm volatile("s_waitcnt vmcnt(0)" ::: "memory");
            const unsigned og = xb_add(&bar[XB_TOP], 1u);
            const unsigned tg = og / nx;
            if (og + 1u == (tg + 1u) * nx) xb_add(&bar[XB_TOPGEN], 1u);
            else XB_SPIN(xb_ld(&bar[XB_TOPGEN]) == tg, bar);
            __builtin_amdgcn_fence(__ATOMIC_ACQUIRE, "agent");
            xb_add(&bar[XB_XGEN(b.x)], 1u);
            asm volatile("s_waitcnt vmcnt(0)" ::: "memory");
        } else {
            XB_SPIN(xb_ld(&bar[XB_XGEN(b.x)]) == gen, bar);
            __builtin_amdgcn_fence(__ATOMIC_ACQUIRE, "agent");
            asm volatile("s_waitcnt vmcnt(0)" ::: "memory");
        }
    }
    __syncthreads();
}

__device__ __forceinline__ void rglru_unit(LAS unsigned char* lds, const Args& a, int b, int g) {
    const int tid = opaque_tid(), lane = tid & 63, w = __builtin_amdgcn_readfirstlane(tid >> 6), lg = lane >> 4, li = lane & 15;
    LAS bf16* Ub = (LAS bf16*)(lds);
    LAS bf16* Wat = (LAS bf16*)(lds + 18432);
    LAS bf16* Wxt = (LAS bf16*)(lds + 27648);
    constexpr int FP = 68;
    LAS float* Uf = (LAS float*)(lds + 36864);
    LAS float* Af = (LAS float*)(lds + 36864 + 34816);
    LAS float* Bf = (LAS float*)(lds + 36864 + 2 * 34816);
    LAS float* Pap = (LAS float*)(lds + 141312);
    LAS float* Phl = (LAS float*)(lds + 143360);
    LAS float* Car = (LAS float*)(lds + 145408);
    const bf16* proj = (const bf16*)(a.ws + WS_A) + (size_t)b * SEQ * NIN;
    bf16* ycat = (bf16*)(a.ws + WS_B) + (size_t)b * SEQ * DM;
    const float* wa = a.in[5] + (size_t)g * 4096; const float* wx = a.in[7] + (size_t)g * 4096;
#pragma unroll
    for (int e = 0; e < 8; ++e) { const int idx = tid + 512 * e, i = idx >> 6, j = idx & 63; Wat[j * 72 + i] = (bf16)(cvtpk(wa[idx], 0.f) & 0xffffu); Wxt[j * 72 + i] = (bf16)(cvtpk(wx[idx], 0.f) & 0xffffu); }
    if (tid < 64) Car[tid] = 0.f;
    const int c2 = tid & 31, tg = tid >> 5, ch0 = 64 * g + 2 * c2;
    float cw[4][2], cb[2];
#pragma unroll
    for (int j = 0; j < 4; ++j) { cw[j][0] = a.in[3][j * 512 + ch0]; cw[j][1] = a.in[3][j * 512 + ch0 + 1]; }
    cb[0] = a.in[4][ch0]; cb[1] = a.in[4][ch0 + 1];
    float cba[4], cbx[4], csp[4];
#pragma unroll
    for (int nt = 0; nt < 4; ++nt) { const int ch = 64 * g + 16 * nt + li; cba[nt] = a.in[6][ch]; cbx[nt] = a.in[8][ch]; const float lam = a.in[9][ch]; csp[nt] = log1pf(__expf(-lam)); }
    const int sc = lane, ss = w;
    unsigned xwr[11];
#pragma unroll
    for (int i = 0; i < 11; ++i) { const int tok = tg * 8 + i - 3; xwr[i] = tok >= 0 ? *(const unsigned*)(proj + (size_t)tok * NIN + ch0) : 0u; }
    for (int ck = 0; ck < SEQ / 128; ++ck) {
        const int s0 = ck * 128;
        BAR_LDS();
        { float xw[11][2];
#pragma unroll
          for (int i = 0; i < 11; ++i) { xw[i][0] = bflo(xwr[i]); xw[i][1] = bfhi(xwr[i]); }
          if (ck + 1 < SEQ / 128) {
#pragma unroll
              for (int i = 0; i < 11; ++i) xwr[i] = *(const unsigned*)(proj + (size_t)(s0 + 128 + tg * 8 + i - 3) * NIN + ch0); }
#pragma unroll
          for (int i = 0; i < 8; ++i) { float u0 = cb[0], u1 = cb[1];
#pragma unroll
              for (int j = 0; j < 4; ++j) { u0 += cw[j][0] * xw[i + j][0]; u1 += cw[j][1] * xw[i + j][1]; }
              const int t = tg * 8 + i; Uf[t * FP + 2 * c2] = u0; Uf[t * FP + 2 * c2 + 1] = u1; *(LAS unsigned*)(Ub + t * 72 + 2 * c2) = cvtpk(u0, u1); } }
        BAR_LDS();
        f32x4 accR[4], accI[4];
#pragma unroll
        for (int nt = 0; nt < 4; ++nt) { accR[nt] = (f32x4){0.f, 0.f, 0.f, 0.f}; accI[nt] = (f32x4){0.f, 0.f, 0.f, 0.f}; }
#pragma unroll
        for (int ks = 0; ks < 2; ++ks) { const bf16x8 af = *(const LAS bf16x8*)(Ub + (16 * w + li) * 72 + 32 * ks + 8 * lg);
#pragma unroll
            for (int nt = 0; nt < 4; ++nt) { const bf16x8 b1 = *(const LAS bf16x8*)(Wat + (16 * nt + li) * 72 + 32 * ks + 8 * lg), b2 = *(const LAS bf16x8*)(Wxt + (16 * nt + li) * 72 + 32 * ks + 8 * lg);
                accR[nt] = __builtin_amdgcn_mfma_f32_16x16x32_bf16(af, b1, accR[nt], 0, 0, 0); accI[nt] = __builtin_amdgcn_mfma_f32_16x16x32_bf16(af, b2, accI[nt], 0, 0, 0); } }
#pragma unroll
        for (int nt = 0; nt < 4; ++nt)
#pragma unroll
            for (int i = 0; i < 4; ++i) { const int t = 16 * w + 4 * lg + i, c = 16 * nt + li;
                const float r = __builtin_amdgcn_rcpf(1.0f + __expf(-(accR[nt][i] + cba[nt]))), ig = __builtin_amdgcn_rcpf(1.0f + __expf(-(accI[nt][i] + cbx[nt])));
                const float la = -8.0f * r * csp[nt]; const float av = __expf(la); const float bv = __builtin_amdgcn_sqrtf(fmaxf(fmaf(-av, av, 1.0f), 0.f)) * (ig * Uf[t * FP + c]);
                Af[t * FP + c] = av; Bf[t * FP + c] = bv; }
        unsigned short gv[16];
#pragma unroll
        for (int i = 0; i < 16; ++i) gv[i] = proj[(size_t)(s0 + 16 * ss + i) * NIN + 512 + 64 * g + sc];
        BAR_LDS();
        float hl[16], ap[16]; { float h = 0.f, p = 1.f;
#pragma unroll
          for (int i = 0; i < 16; ++i) { const float av = Af[(16 * ss + i) * FP + sc], bv = Bf[(16 * ss + i) * FP + sc]; h = av * h + bv; p *= av; hl[i] = h; ap[i] = p; }
          Pap[ss * 64 + sc] = p; Phl[ss * 64 + sc] = h; }
        BAR_LDS();
        float hin = Car[(ck & 1) * 64 + sc];
        for (int j = 0; j < ss; ++j) hin = Pap[j * 64 + sc] * hin + Phl[j * 64 + sc];
#pragma unroll
        for (int i = 0; i < 16; ++i) { const float h = hl[i] + ap[i] * hin; const float x = bflo(gv[i]); const float z = 0.7978845608028654f * (x + 0.044715f * x * x * x);
            const float ge = x * __builtin_amdgcn_rcpf(1.0f + __expf(-2.0f * z)); ycat[(size_t)(s0 + 16 * ss + i) * DM + 64 * g + sc] = (bf16)(cvtpk(h * ge, 0.f) & 0xffffu);
            if (i == 15 && ss == 7) Car[((ck + 1) & 1) * 64 + sc] = h; }
    }
    BAR_LDS();
}
typedef short v4i16_t __attribute__((ext_vector_type(4)));
__device__ __forceinline__ u32x2 tr_read4(const LAS bf16* p) { return __builtin_bit_cast(u32x2, __builtin_amdgcn_ds_read_tr16_b64_v4i16((LAS v4i16_t*)p)); }
__device__ __forceinline__ float score_bound(const float* qg, const float* kg, int lane) {
    float a = fabsf(qg[lane]), b = fabsf(kg[lane]);
#pragma unroll
    for (int o = 1; o < 64; o <<= 1) { a = fmaxf(a, __shfl_xor(a, o)); b = fmaxf(b, __shfl_xor(b, o)); }
    return 8.0f * 1.4426950408889634f * a * b * 1.01f + 0.5f;
}
struct AttnArgs {
    const bf16* Q; const bf16* K; const bf16* V; int ld;
    int qc0, T1;
    bf16* O; int ldo; float lam; const float* subg; float mb;
};
__device__ __forceinline__ void diff_unit(LAS unsigned char* lds, const AttnArgs A) {
    constexpr int NC = 2, DV = 128, QP = NC * 64 + 8, VP = DV + 16, NDT = DV / 16, NVH = DV / 64;
    const int tid = opaque_tid(), lane = tid & 63, w = __builtin_amdgcn_readfirstlane(tid >> 6), lg = lane >> 4, li = lane & 15;
    constexpr int TBUF = 64 * QP + 64 * VP;
    const int krow = tid >> 3, c8 = tid & 7;
    u32x4 kraw[NC], vraw[NVH];
#define ATT_LOAD(T) do { const int tk_ = 64 * (T) + krow; \
        _Pragma("unroll") for (int c = 0; c < NC; ++c) kraw[c] = *(const u32x4*)(A.K + (size_t)tk_ * A.ld + c * 64 + 8 * c8); \
        _Pragma("unroll") for (int hh = 0; hh < NVH; ++hh) vraw[hh] = *(const u32x4*)(A.V + (size_t)tk_ * A.ld + hh * 64 + 8 * c8); } while (0)
#define ATT_WRITE(buf) do { LAS bf16* Ks_ = (LAS bf16*)lds + (buf) * TBUF; LAS bf16* Vs_ = Ks_ + 64 * QP; \
        _Pragma("unroll") for (int c = 0; c < NC; ++c) *(LAS u32x4*)(Ks_ + krow * QP + c * 64 + 8 * c8) = kraw[c]; \
        _Pragma("unroll") for (int hh = 0; hh < NVH; ++hh) *(LAS u32x4*)(Vs_ + krow * VP + hh * 64 + 8 * c8) = vraw[hh]; } while (0)
    ATT_LOAD(0);
    const int qw = A.qc0 + 16 * w, qc = qw + li;
    bf16x8 qf[NC][2];
#pragma unroll
    for (int c = 0; c < NC; ++c)
#pragma unroll
        for (int ks = 0; ks < 2; ++ks) qf[c][ks] = *(const bf16x8*)(A.Q + (size_t)qc * A.ld + c * 64 + 32 * ks + 8 * lg);
    float lrun[NC]; f32x4 O[NC][NDT];
#pragma unroll
    for (int c = 0; c < NC; ++c) { lrun[c] = 0.f;
#pragma unroll
        for (int dt = 0; dt < NDT; ++dt) O[c][dt] = (f32x4){0.f, 0.f, 0.f, 0.f}; }
    const float nmb = -A.mb;
    BAR_LDS();
    ATT_WRITE(0);
    if (1 < A.T1) ATT_LOAD(1);
    BAR_LDS();
    for (int T = 0; T < A.T1; ++T) {
        const LAS bf16* Ks = (const LAS bf16*)lds + (T & 1) * TBUF; const LAS bf16* Vs = Ks + 64 * QP;
        const int k0 = 64 * T;
        if (k0 <= qw + 15) {
            const bool domask = (k0 + 63 > qw);
            bf16x8 pf[NC][2];
#pragma unroll
            for (int c = 0; c < NC; ++c) {
                f32x4 s[4];
#pragma unroll
                for (int nt = 0; nt < 4; ++nt) { s[nt] = (f32x4){nmb, nmb, nmb, nmb};
#pragma unroll
                    for (int ks = 0; ks < 2; ++ks) { const bf16x8 kf = *(const LAS bf16x8*)(Ks + (16 * nt + li) * QP + c * 64 + 32 * ks + 8 * lg); s[nt] = __builtin_amdgcn_mfma_f32_16x16x32_bf16(kf, qf[c][ks], s[nt], 0, 0, 0); } }
                if (domask) {
#pragma unroll
                    for (int nt = 0; nt < 4; ++nt)
#pragma unroll
                        for (int i = 0; i < 4; ++i) { const int kc = k0 + 16 * nt + 4 * lg + i; if (kc > qc) s[nt][i] = -1e30f; }
                }
                float lsum = 0.f;
#pragma unroll
                for (int nt = 0; nt < 4; ++nt)
#pragma unroll
                    for (int i = 0; i < 4; ++i) { const float p = __builtin_amdgcn_exp2f(s[nt][i]); s[nt][i] = p; lsum += p; }
                lrun[c] += lsum;
#pragma unroll
                for (int kp = 0; kp < 2; ++kp) { u32x4 pk; pk.x = cvtpk(s[2 * kp][0], s[2 * kp][1]); pk.y = cvtpk(s[2 * kp][2], s[2 * kp][3]); pk.z = cvtpk(s[2 * kp + 1][0], s[2 * kp + 1][1]); pk.w = cvtpk(s[2 * kp + 1][2], s[2 * kp + 1][3]); pf[c][kp] = __builtin_bit_cast(bf16x8, pk); }
            }
#pragma unroll
            for (int dt = 0; dt < NDT; ++dt)
#pragma unroll
                for (int kp = 0; kp < 2; ++kp) { const u32x2 lo = tr_read4(Vs + (32 * kp + 4 * lg + (li >> 2)) * VP + 16 * dt + 4 * (li & 3)), hi = tr_read4(Vs + (32 * kp + 16 + 4 * lg + (li >> 2)) * VP + 16 * dt + 4 * (li & 3));
                    u32x4 vv; vv.x = lo.x; vv.y = lo.y; vv.z = hi.x; vv.w = hi.y; const bf16x8 vf = __builtin_bit_cast(bf16x8, vv);
#pragma unroll
                    for (int c = 0; c < NC; ++c) O[c][dt] = __builtin_amdgcn_mfma_f32_16x16x32_bf16(vf, pf[c][kp], O[c][dt], 0, 0, 0); }
        }
        if (T + 1 < A.T1) { ATT_WRITE((T + 1) & 1); if (T + 2 < A.T1) ATT_LOAD(T + 2); }
        BAR_LDS();
    }
#undef ATT_LOAD
#undef ATT_WRITE
    float lt[NC];
#pragma unroll
    for (int c = 0; c < NC; ++c) { float l = lrun[c]; l += __shfl_xor(l, 16); l += __shfl_xor(l, 32); lt[c] = l; }
    const float i0 = 1.0f / lt[0], i1 = A.lam / lt[1]; float ssq = 0.f;
#pragma unroll
    for (int dt = 0; dt < NDT; ++dt) { O[0][dt] = O[0][dt] * i0 - O[1][dt] * i1; ssq += (O[0][dt][0] * O[0][dt][0] + O[0][dt][1] * O[0][dt][1]) + (O[0][dt][2] * O[0][dt][2] + O[0][dt][3] * O[0][dt][3]); }
    ssq += __shfl_xor(ssq, 16); ssq += __shfl_xor(ssq, 32);
    const float rs = rsqrtf(ssq * (1.0f / (float)DV) + 1e-6f) * 0.8f;
#pragma unroll
    for (int dt = 0; dt < NDT; ++dt) { const f32x4 gg = *(const f32x4*)(A.subg + 16 * dt + 4 * lg); const f32x4 o = O[0][dt] * gg * rs; u32x2 wv; wv.x = cvtpk(o[0], o[1]); wv.y = cvtpk(o[2], o[3]); *(u32x2*)(A.O + (size_t)qc * A.ldo + 16 * dt + 4 * lg) = wv; }
}

struct DilUnit { const bf16* Q; const bf16* K; const bf16* V; bf16* O; float* lse; int dil, r, n, kbeg, nk; };
__device__ __forceinline__ bf16* op_buf(unsigned char* ws, int p) { return (bf16*)(ws + (p == 0 ? WS_B : (p == 1 ? WS_XB : WS_C))); }
__device__ __forceinline__ DilUnit dil_decode(const Args& a, int i, int G) {
    const int it = blockIdx.x + i * G; const int u = it % 48, bh = it / 48;
    const int b = bh >> 4, h = bh & 15;
    int p, dil, r, n;
    if (u < 16) { p = 0; dil = 1; r = 0; n = u; } else if (u < 32) { p = 1; dil = 4; r = (u - 16) >> 2; n = (u - 16) & 3; } else { p = 2; dil = 16; r = u - 32; n = 0; }
    const bf16* qkv = (const bf16*)(a.ws + WS_A) + (size_t)b * SEQ * NQKV + 64 * h;
    DilUnit U; U.Q = qkv; U.K = qkv + 1024; U.V = qkv + 2048; U.O = op_buf(a.ws, p) + (size_t)b * SEQ * DM + 64 * h;
    U.lse = (float*)(a.ws + WS_LSE) + (size_t)p * MROWS * 16 + (size_t)b * SEQ * 16 + h; U.dil = dil; U.r = r; U.n = n; U.kbeg = n > 0 ? 128 * (n - 1) : 0; U.nk = n > 0 ? 256 : 128;
    return U;
}
template <bool PREV>
__device__ __forceinline__ void dil_compute(const LAS bf16* Ks, const LAS bf16* Vs, bf16x8 qf0, bf16x8 qf1, int w, int lg, int li, float mb, f32x4 (&O)[4], float& lsum_out) {
    constexpr int KP = 72, NS = PREV ? 9 : 8, NPAIR = PREV ? 5 : 4;
    const int st0 = PREV ? w : 0;
    f32x4 s[10];
    {
        bf16x8 kA[NS], kB[NS];
#pragma unroll
        for (int j = 0; j < NS; ++j) { const int st = st0 + j; kA[j] = *(const LAS bf16x8*)(Ks + (16 * st + li) * KP + 8 * lg); kB[j] = *(const LAS bf16x8*)(Ks + (16 * st + li) * KP + 32 + 8 * lg); }
        __builtin_amdgcn_sched_barrier(0);
        const f32x4 zc = {-mb, -mb, -mb, -mb};
#pragma unroll
        for (int j = 0; j < NS; ++j) s[j] = __builtin_amdgcn_mfma_f32_16x16x32_bf16(kA[j], qf0, zc, 0, 0, 0);
#pragma unroll
        for (int j = 0; j < NS; ++j) s[j] = __builtin_amdgcn_mfma_f32_16x16x32_bf16(kB[j], qf1, s[j], 0, 0, 0);
    }
    u32x2 vlo[NPAIR][4], vhi[NPAIR][4];
#pragma unroll
    for (int kp = 0; kp < NPAIR; ++kp) { const int sa = st0 + 2 * kp; int sb = sa + 1; if (PREV && sb > 15) sb = 15;
#pragma unroll
        for (int dt = 0; dt < 4; ++dt) { vlo[kp][dt] = tr_read4(Vs + (16 * sa + 4 * lg + (li >> 2)) * KP + 16 * dt + 4 * (li & 3)); vhi[kp][dt] = tr_read4(Vs + (16 * sb + 4 * lg + (li >> 2)) * KP + 16 * dt + 4 * (li & 3)); } }
    __builtin_amdgcn_sched_barrier(0);
    if (PREV) {
#pragma unroll
        for (int e = 0; e < 4; ++e) { if (li > 4 * lg + e) s[0][e] = -1e30f; if (4 * lg + e > li) s[8][e] = -1e30f; }
    } else {
        const int qrel = 16 * w + li;
#pragma unroll
        for (int j = 0; j < NS; ++j)
#pragma unroll
            for (int e = 0; e < 4; ++e) if (16 * j + 4 * lg + e > qrel) s[j][e] = -1e30f;
    }
    float lsum = 0.f;
#pragma unroll
    for (int j = 0; j < NS; ++j)
#pragma unroll
        for (int e = 0; e < 4; ++e) { const float p = __builtin_amdgcn_exp2f(s[j][e]); s[j][e] = p; lsum += p; }
#pragma unroll
    for (int j = NS; j < 10; ++j) s[j] = (f32x4){0.f, 0.f, 0.f, 0.f};
#pragma unroll
    for (int dt = 0; dt < 4; ++dt) O[dt] = (f32x4){0.f, 0.f, 0.f, 0.f};
#pragma unroll
    for (int kp = 0; kp < NPAIR; ++kp) {
        u32x4 pk; pk.x = cvtpk(s[2 * kp][0], s[2 * kp][1]); pk.y = cvtpk(s[2 * kp][2], s[2 * kp][3]); pk.z = cvtpk(s[2 * kp + 1][0], s[2 * kp + 1][1]); pk.w = cvtpk(s[2 * kp + 1][2], s[2 * kp + 1][3]);
        const bf16x8 pf = __builtin_bit_cast(bf16x8, pk);
#pragma unroll
        for (int dt = 0; dt < 4; ++dt) { u32x4 vv; vv.x = vlo[kp][dt].x; vv.y = vlo[kp][dt].y; vv.z = vhi[kp][dt].x; vv.w = vhi[kp][dt].y; O[dt] = __builtin_amdgcn_mfma_f32_16x16x32_bf16(__builtin_bit_cast(bf16x8, vv), pf, O[dt], 0, 0, 0); }
    }
    lsum += __shfl_xor(lsum, 16); lsum = pg8::sum_xor32(lsum);
    lsum_out = lsum;
}
__device__ __forceinline__ void dil_store(const f32x4 (&O)[4], float lsum, float mb, int lg, bf16* Orow, float* lsep) {
    const float inv = 1.0f / lsum;
#pragma unroll
    for (int dt = 0; dt < 4; ++dt) { const f32x4 o = O[dt] * inv; u32x2 wv; wv.x = cvtpk(o[0], o[1]); wv.y = cvtpk(o[2], o[3]); *(u32x2*)(Orow + 16 * dt + 4 * lg) = wv; }
    if (lg == 0) *lsep = (mb + __log2f(lsum)) * 0.6931471805599453f;
}
__device__ __forceinline__ void p7_dilated(const Args& a, LAS unsigned char* lds) {
    constexpr int KP = 72, KBYTES = 256 * KP * 2, BUF = 2 * KBYTES, NTOT = BATCH * 16 * 48;
    const int tid = opaque_tid(), lane = tid & 63, w = __builtin_amdgcn_readfirstlane(tid >> 6), lg = lane >> 4, li = lane & 15, krow = tid >> 3, c8 = tid & 7;
    const int G = gridDim.x;
    const float mb = score_bound(a.in[20], a.in[21], lane);
    const int nun = (NTOT - (int)blockIdx.x + G - 1) / G;
    u32x4 kr[4], vr[4]; bf16x8 qn[2];
    DilUnit U = dil_decode(a, 0, G);
#define DIL_LOAD() do { \
        _Pragma("unroll") for (int j = 0; j < 4; ++j) if (64 * j < U.nk) { \
            kr[j] = *(const u32x4*)(U.K + (size_t)((U.kbeg + krow + 64 * j) * U.dil + U.r) * NQKV + 8 * c8); \
            vr[j] = *(const u32x4*)(U.V + (size_t)((U.kbeg + krow + 64 * j) * U.dil + U.r) * NQKV + 8 * c8); } \
        _Pragma("unroll") for (int ks = 0; ks < 2; ++ks) qn[ks] = *(const bf16x8*)(U.Q + (size_t)((128 * U.n + 16 * w + li) * U.dil + U.r) * NQKV + 32 * ks + 8 * lg); } while (0)
#define DIL_WRITE(buf) do { LAS bf16* Ks_ = (LAS bf16*)(lds + (buf) * BUF); LAS bf16* Vs_ = (LAS bf16*)(lds + (buf) * BUF + KBYTES); \
        _Pragma("unroll") for (int j = 0; j < 4; ++j) if (64 * j < U.nk) { \
            *(LAS u32x4*)(Ks_ + (krow + 64 * j) * KP + 8 * c8) = kr[j]; *(LAS u32x4*)(Vs_ + (krow + 64 * j) * KP + 8 * c8) = vr[j]; } } while (0)
    BAR_LDS();
    if (nun > 0) { DIL_LOAD(); DIL_WRITE(0); }
    BAR_LDS();
    DilUnit C = U; bf16x8 qf0 = qn[0], qf1 = qn[1];
    for (int i = 0; i < nun; ++i) {
        const bool more = i + 1 < nun;
        if (more) { U = dil_decode(a, i + 1, G); DIL_LOAD(); }
        const LAS bf16* Ks = (const LAS bf16*)(lds + (i & 1) * BUF); const LAS bf16* Vs = (const LAS bf16*)(lds + (i & 1) * BUF + KBYTES);
        f32x4 O[4]; float lsum;
        if (C.n > 0) dil_compute<true>(Ks, Vs, qf0, qf1, w, lg, li, mb, O, lsum);
        else dil_compute<false>(Ks, Vs, qf0, qf1, w, lg, li, mb, O, lsum);
        const int tokq = (128 * C.n + 16 * w + li) * C.dil + C.r; bf16* Orow = C.O + (size_t)tokq * DM; float* lsep = C.lse + (size_t)tokq * 16;
        if (more) { DIL_WRITE((i + 1) & 1); qf0 = qn[0]; qf1 = qn[1]; C = U; }
        asm volatile("" :: "v"(qf0), "v"(qf1));
        dil_store(O, lsum, mb, lg, Orow, lsep);
        BAR_LDS();
    }
#undef DIL_LOAD
#undef DIL_WRITE
}
__device__ __forceinline__ int next_item(LAS unsigned char* lds, unsigned* ctr) {
    LAS int* slot = (LAS int*)(lds + LDS_ITEM);
    __syncthreads();
    if (threadIdx.x == 0) *slot = (int)__hip_atomic_fetch_add(ctr, 1u, __ATOMIC_RELAXED, __HIP_MEMORY_SCOPE_AGENT);
    __syncthreads();
    return *slot;
}
__device__ __forceinline__ void p2_mixers(const Args& a, LAS unsigned char* lds, int coff) {
    const int lane = opaque_tid() & 63;
    float lam; { const float d1 = wave_sum(a.in[12][lane] * a.in[13][lane]), d2 = wave_sum(a.in[14][lane] * a.in[15][lane]); lam = __expf(d1) - __expf(d2) + 0.2f; }
    unsigned* ctr = (unsigned*)(a.ws + WS_CTL) + coff;
    const float mb = score_bound(a.in[10], a.in[11], lane);
    constexpr int NATT = BATCH * 4 * 16;
#ifndef NO_RGLRU
    for (;;) {
        const int it = next_item(lds, ctr);
        if (it >= 128) break;
        rglru_unit(lds, a, it >> 3, it & 7);
    }
#if PROBE == 20
    for (;;) {
        const int it = next_item(lds, ctr + 16);
        if (it >= 128) break;
        rglru_unit(lds, a, it >> 3, it & 7);
    }
#endif
#endif
#ifndef NO_DIFF
    {
        LAS int* slot = (LAS int*)(lds + LDS_ITEM);
        int j = next_item(lds, ctr + 2);
        while (j < NATT) {
            unsigned nxt = 0u; if (threadIdx.x == 0) nxt = __hip_atomic_fetch_add(ctr + 2, 1u, __ATOMIC_RELAXED, __HIP_MEMORY_SCOPE_AGENT);
            const int qb = 15 - (j >> 6), bh = j & 63, b = bh >> 2, h = bh & 3;
            const bf16* proj = (const bf16*)(a.ws + WS_A) + (size_t)b * SEQ * NIN;
            AttnArgs A; A.Q = proj + 1024 + 128 * h; A.K = proj + 1536 + 128 * h; A.V = proj + 2048 + 128 * h; A.ld = NIN;
            A.qc0 = 128 * qb; A.T1 = 2 * qb + 2;
            A.O = (bf16*)(a.ws + WS_B) + (size_t)b * SEQ * DM + 512 + 128 * h; A.ldo = DM; A.lam = lam; A.subg = a.in[16]; A.mb = mb;
            diff_unit(lds, A);
            if (threadIdx.x == 0) *slot = (int)nxt;
            BAR_LDS();
            j = *slot;
        }
    }
#endif
}
__device__ __forceinline__ void p7b_merge(const Args& a) {
    const int gt = blockIdx.x * 512 + opaque_tid(), NGT = gridDim.x * 512;
    const float* lse = (const float*)(a.ws + WS_LSE);
    bf16* o0 = op_buf(a.ws, 0); const bf16* o1 = op_buf(a.ws, 1); const bf16* o2 = op_buf(a.ws, 2);
    for (int i0 = gt; i0 < MROWS * 128; i0 += 4 * NGT) {
        float l0[4], l1[4], l2[4]; u32x4 v0[4], v1[4], v2[4];
#pragma unroll
        for (int k = 0; k < 4; ++k) { const int i = i0 + k * NGT; const int row = i >> 7, hc = i & 127, h = hc >> 3; const size_t off = (size_t)row * DM + 8 * hc;
            l0[k] = lse[(size_t)row * 16 + h]; l1[k] = lse[(size_t)MROWS * 16 + (size_t)row * 16 + h]; l2[k] = lse[(size_t)2 * MROWS * 16 + (size_t)row * 16 + h];
            v0[k] = *(const u32x4*)(o0 + off); v1[k] = *(const u32x4*)(o1 + off); v2[k] = *(const u32x4*)(o2 + off); }
#pragma unroll
        for (int k = 0; k < 4; ++k) { const int i = i0 + k * NGT; const int row = i >> 7, hc = i & 127; const size_t off = (size_t)row * DM + 8 * hc;
            const float mx = fmaxf(l0[k], fmaxf(l1[k], l2[k])); float e0 = __expf(l0[k] - mx), e1 = __expf(l1[k] - mx), e2 = __expf(l2[k] - mx); const float inv = 1.0f / (e0 + e1 + e2); e0 *= inv; e1 *= inv; e2 *= inv;
            u32x4 o;
            o.x = cvtpk(e0 * bflo(v0[k].x) + e1 * bflo(v1[k].x) + e2 * bflo(v2[k].x), e0 * bfhi(v0[k].x) + e1 * bfhi(v1[k].x) + e2 * bfhi(v2[k].x));
            o.y = cvtpk(e0 * bflo(v0[k].y) + e1 * bflo(v1[k].y) + e2 * bflo(v2[k].y), e0 * bfhi(v0[k].y) + e1 * bfhi(v1[k].y) + e2 * bfhi(v2[k].y));
            o.z = cvtpk(e0 * bflo(v0[k].z) + e1 * bflo(v1[k].z) + e2 * bflo(v2[k].z), e0 * bfhi(v0[k].z) + e1 * bfhi(v1[k].z) + e2 * bfhi(v2[k].z));
            o.w = cvtpk(e0 * bflo(v0[k].w) + e1 * bflo(v1[k].w) + e2 * bflo(v2[k].w), e0 * bfhi(v0[k].w) + e1 * bfhi(v1[k].w) + e2 * bfhi(v2[k].w));
            *(u32x4*)(o0 + off) = o; }
    }
}

template <class Epi> __device__ __forceinline__ void run_gemm(LAS unsigned char* lds, const bf16* A, const bf16* Bt, int N, int K, const Epi& E) {
    pg8::Gemm g{A, Bt, MROWS, N, K}; pg8::StaticOrder S; S.init(MROWS, N, (int)gridDim.x, (int)blockIdx.x);
    pg8::gemm_phase<Epi, pg8::StaticOrder, true, true>(lds, g, S, E);
}
#ifndef PHMASK
#define PHMASK 0xfff
#endif
#ifndef PROBE
#define PROBE -1
#endif
#define REP(n) for (int rep = 0; rep < 1; ++rep)
#if PROBE == 30
#define GSYNC() do { xcd_barrier(xbar); xcd_barrier(xbar); } while (0)
#else
#define GSYNC() xcd_barrier(xbar)
#endif
#define DUP(n, ...) do { if ((PROBE) == (n)) { __VA_ARGS__; } } while (0)
__global__ void __launch_bounds__(512) fwd_megakernel(Args a) {
    extern __shared__ __attribute__((aligned(16))) unsigned char lds_raw[];
    LAS unsigned char* lds = (LAS unsigned char*)lds_raw;
    cg::grid_group grid = cg::this_grid();
    unsigned char* ws = a.ws;
    float* ssq = (float*)(ws + WS_SSQ); const float* ropec = (const float*)(ws + WS_ROPE);
    bf16* xb = (bf16*)(ws + WS_XB); bf16* bufA = (bf16*)(ws + WS_A); bf16* bufB = (bf16*)(ws + WS_B);
    REP(0) { p0_prologue(a, lds); } DUP(0, p0_prologue(a, lds));
    if (threadIdx.x < 2) ((LAS unsigned*)(lds + LDS_BARST))[threadIdx.x] = 0u;
    grid.sync();
    const XcdBarrier xbar = xcd_barrier_post((unsigned*)(ws + WS_CTL) + CW_BAR, (volatile LAS unsigned*)(lds + LDS_BARST));
    REP(1) { run_gemm(lds, xb, (const bf16*)(ws + WS_WIN), NIN, DM, pg8::EpiQK{bufA, NIN, ssq, 4, 6, 8, a.in[10], a.in[11], ropec, ropec + SEQ * 8, (LAS float*)(lds + 131072)}); }
    GSYNC();
    REP(2) { p2_mixers(a, lds, 0); } DUP(2, p2_mixers(a, lds, 8));
    GSYNC();
    { run_gemm(lds, bufB, (const bf16*)(ws + WS_WO0), DM, DM, pg8::EpiResid{a.in[0], a.out, xb, ssq + MROWS}); }
    DUP(3, run_gemm(lds, bufB, (const bf16*)(ws + WS_WO0), DM, DM, pg8::EpiScale{bufA, DM, ssq}));
    GSYNC();
    REP(4) { run_gemm(lds, xb, (const bf16*)(ws + WS_WGU0), 2 * DFF, DM, pg8::EpiSwiGLU{bufA, ssq + MROWS}); } DUP(4, run_gemm(lds, xb, (const bf16*)(ws + WS_WGU0), 2 * DFF, DM, pg8::EpiSwiGLU{bufA, ssq + MROWS}));
    GSYNC();
    { run_gemm(lds, bufA, (const bf16*)(ws + WS_WDN0), DM, DFF, pg8::EpiResid{a.out, a.out, xb, ssq + 2 * MROWS}); }
    DUP(5, run_gemm(lds, bufA, (const bf16*)(ws + WS_WDN0), DM, DFF, pg8::EpiScale{bufB, DM, ssq}));
    GSYNC();
    REP(6) { run_gemm(lds, xb, (const bf16*)(ws + WS_WQKV), NQKV, DM, pg8::EpiQK{bufA, NQKV, ssq + 2 * MROWS, 0, 4, 8, a.in[20], a.in[21], ropec, ropec + SEQ * 8, (LAS float*)(lds + 131072)}); }
    GSYNC();
    REP(7) { p7_dilated(a, lds); } DUP(7, p7_dilated(a, lds));
    GSYNC();
    p7b_merge(a);
    GSYNC();
    { run_gemm(lds, bufB, (const bf16*)(ws + WS_WO1), DM, DM, pg8::EpiResid{a.out, a.out, xb, ssq + 3 * MROWS}); }
    GSYNC();
    REP(10) { run_gemm(lds, xb, (const bf16*)(ws + WS_WGU1), 2 * DFF, DM, pg8::EpiSwiGLU{bufA, ssq + 3 * MROWS}); }
    GSYNC();
    { run_gemm(lds, bufA, (const bf16*)(ws + WS_WDN1), DM, DFF, pg8::EpiResid{a.out, a.out, nullptr, nullptr}); }
}

extern "C" void kernel_launch(void* const* d_in, const int* in_sizes, int n_in, void* d_out, int out_size, void* d_ws, size_t ws_size, hipStream_t stream) {
    static int grid = 0;
    if (grid == 0) {
        if (n_in != 27 || out_size != MROWS * DM || ws_size < WS_END) { fprintf(stderr, "kernel_launch: unexpected shapes (n_in %d, out %d, ws %zu)\n", n_in, out_size, ws_size); grid = -1; return; }
        int dev = 0, cus = 0, per_cu = 0;
        hipGetDevice(&dev); hipDeviceGetAttribute(&cus, hipDeviceAttributeMultiprocessorCount, dev);
        if (hipFuncSetAttribute((const void*)fwd_megakernel, hipFuncAttributeMaxDynamicSharedMemorySize, LDS_BYTES) != hipSuccess) { fprintf(stderr, "kernel_launch: hipFuncSetAttribute failed\n"); grid = -1; return; }
        if (hipOccupancyMaxActiveBlocksPerMultiprocessor(&per_cu, (const void*)fwd_megakernel, 512, LDS_BYTES) != hipSuccess || per_cu < 1) { fprintf(stderr, "kernel_launch: occupancy query failed (%d)\n", per_cu); (void)hipGetLastError(); per_cu = 1; }
        grid = cus * (per_cu > 1 ? 1 : per_cu);
        fprintf(stderr, "kernel_launch: grid %d (cus %d, per_cu %d)\n", grid, cus, per_cu);
    }
    if (grid < 0) return;
    Args a{};
    for (int i = 0; i < 27; ++i) a.in[i] = (const float*)d_in[i];
    a.out = (float*)d_out; a.ws = (unsigned char*)d_ws;
    void* args[] = {&a};
    hipError_t e = hipLaunchCooperativeKernel((const void*)fwd_megakernel, dim3(grid), dim3(512), args, LDS_BYTES, stream);
    if (e != hipSuccess) fprintf(stderr, "kernel_launch: cooperative launch failed: %s (grid %d)\n", hipGetErrorString(e), grid);
}
```

```cpp
#include <hip/hip_runtime.h>
#include <hip/hip_cooperative_groups.h>
#include <cstdio>
#include <cstdint>
namespace cg = cooperative_groups;
__device__ __forceinline__ int opaque_tid() { int t = threadIdx.x; asm volatile("" : "+v"(t)); return t; }
#define BAR_LDS() asm volatile("s_waitcnt lgkmcnt(0)\n\ts_barrier" ::: "memory")
namespace pg8 {
#define PG8_LAS __attribute__((address_space(3)))
typedef unsigned short bf16_t;
typedef short bf16x8 __attribute__((ext_vector_type(8)));
typedef float f32x4 __attribute__((ext_vector_type(4)));
typedef unsigned u32x4 __attribute__((ext_vector_type(4)));
constexpr int BM = 256, BK = 64, HALF = 128, HTB = HALF * BK * 2  , STAGE_BYTES = 8 * HTB, NXCD = 8, WGM = 4;

__host__ __device__ __forceinline__ int lds_byte(int r, int c) { const int st = (r >> 4) * 2 + (c >> 5), rr = r & 15, cc = c & 31, ob = rr * 64 + cc * 2; return st * 1024 + (ob ^ (((ob >> 9) & 1) << 5)); }
__host__ __device__ __forceinline__ void stage_rc(int b, int& R, int& C) { const int st = b / 1024, sb = b % 1024, swz = sb ^ (((sb >> 9) & 1) << 5); R = (st >> 1) * 16 + swz / 64; C = (st & 1) * 32 + (swz % 64) / 2; }
__host__ __device__ __forceinline__ int perm32(int rho) { const int n = rho >> 4, i = rho & 15; return 8 * (i >> 2) + 4 * n + (i & 3); }

struct Unit { int pm, pn; };
struct Gemm { const bf16_t* A; const bf16_t* Bt; int M, N, K; };

struct StaticOrder {
    int nM, nN, nwg, G, c;
    __host__ __device__ void init(int M, int N, int G_, int c_) { nM = M / BM; nN = N / BM; nwg = nM * nN; G = G_; c = c_; }
    __host__ __device__ bool next(int i, Unit& u) const {
        const long L = (long)i * G + c; if (L >= nwg) return false;
        int wgid = (int)L; { const int q = nwg / NXCD, r = nwg % NXCD, xcd = wgid % NXCD, off = wgid / NXCD; wgid = (xcd < r ? xcd * (q + 1) : r * (q + 1) + (xcd - r) * q) + off; }
        const int nig = WGM * nN, gid = wgid / nig, fm = gid * WGM, gsz = (nM - fm) < WGM ? (nM - fm) : WGM;
        u.pm = fm + ((wgid % nig) % gsz); u.pn = (wgid % nig) / gsz; return true;
    }
    __device__ __forceinline__ void a_ready(const Unit&) const {}
    __device__ __forceinline__ void done(const Unit&) const {}
};

__device__ __forceinline__ unsigned cvt_pk_bf16(float lo, float hi) { unsigned r; asm volatile("v_cvt_pk_bf16_f32 %0, %1, %2" : "=v"(r) : "v"(lo), "v"(hi)); return r; }
typedef float f32x2 __attribute__((ext_vector_type(2)));
__device__ __forceinline__ float sum_xor32(float x) { const unsigned u = __builtin_bit_cast(unsigned, x); auto r = __builtin_amdgcn_permlane32_swap(u, u, false, false); return __builtin_bit_cast(float, (unsigned)r[0]) + __builtin_bit_cast(float, (unsigned)r[1]); }
__device__ __forceinline__ float other_half(float x, bool upper) { const unsigned u = __builtin_bit_cast(unsigned, x); auto r = __builtin_amdgcn_permlane32_swap(u, u, false, false); return __builtin_bit_cast(float, (unsigned)(upper ? r[0] : r[1])); }
__device__ __forceinline__ float other_row16(float x, bool oddrow) { const unsigned u = __builtin_bit_cast(unsigned, x); auto r = __builtin_amdgcn_permlane16_swap(u, u, false, false); return __builtin_bit_cast(float, (unsigned)(oddrow ? r[0] : r[1])); }
__device__ __forceinline__ float rstd_of(const float* ssq, int row) { return rsqrtf(ssq[row] * (1.0f / 1024.0f) + 1e-6f); }
typedef unsigned u32x2 __attribute__((ext_vector_type(2)));
struct EpiScale {
    static constexpr bool PERM = false, AFTER_DRAIN = false;
    bf16_t* O; int ldc; const float* ssq;
    __device__ __forceinline__ void operator()(const f32x4 (&acc)[2][2][4][2], const Unit& u, int wr, int wc, int fr, int fq) const {
        const int row0 = u.pm * BM + wr * 64 + fr, col0 = u.pn * BM + wc * 32 + 4 * fq;
#pragma unroll
        for (int ai = 0; ai < 2; ++ai)
#pragma unroll
            for (int m = 0; m < 4; ++m) { const int row = row0 + ai * HALF + m * 16; const float rs = rstd_of(ssq, row); bf16_t* rp = O + (size_t)row * ldc + col0;
#pragma unroll
                for (int bj = 0; bj < 2; ++bj)
#pragma unroll
                    for (int n = 0; n < 2; ++n) { const f32x4 v = acc[ai][bj][m][n] * rs; u32x2 w; w.x = cvt_pk_bf16(v[0], v[1]); w.y = cvt_pk_bf16(v[2], v[3]); *(u32x2*)(rp + bj * HALF + n * 16) = w; } }
    }
};
struct EpiResid {
    static constexpr bool PERM = true, AFTER_DRAIN = false;
    const float* xin; float* xout; bf16_t* xb; float* ssq_next;
    __device__ __forceinline__ void operator()(const f32x4 (&acc)[2][2][4][2], const Unit& u, int wr, int wc, int fr_in, int fq_in) const {
        int fr = fr_in, fq = fq_in; asm volatile("" : "+v"(fr), "+v"(fq));
        const int row0 = u.pm * BM + wr * 64 + fr, col0 = u.pn * BM + wc * 32 + 8 * fq;
#pragma unroll
        for (int ai = 0; ai < 2; ++ai) {
            f32x4 pre[4][2][2];
#pragma unroll
            for (int m = 0; m < 4; ++m) { const size_t off = (size_t)(row0 + ai * HALF + m * 16) * 1024 + col0;
#pragma unroll
                for (int bj = 0; bj < 2; ++bj)
#pragma unroll
                    for (int n = 0; n < 2; ++n) pre[m][bj][n] = *(const f32x4*)(xin + off + bj * HALF + 4 * n); }
#pragma unroll
            for (int m = 0; m < 4; ++m) { const int row = row0 + ai * HALF + m * 16; const size_t off = (size_t)row * 1024 + col0; float s = 0.f;
#pragma unroll
                for (int bj = 0; bj < 2; ++bj) { const size_t o2 = off + bj * HALF;
                    const f32x4 x0 = pre[m][bj][0] + acc[ai][bj][m][0], x1 = pre[m][bj][1] + acc[ai][bj][m][1];
                    *(f32x4*)(xout + o2) = x0; *(f32x4*)(xout + o2 + 4) = x1;
                    if (xb) { u32x4 w; w.x = cvt_pk_bf16(x0[0], x0[1]); w.y = cvt_pk_bf16(x0[2], x0[3]); w.z = cvt_pk_bf16(x1[0], x1[1]); w.w = cvt_pk_bf16(x1[2], x1[3]); *(u32x4*)(xb + o2) = w;
                        s += ((x0[0] * x0[0] + x0[1] * x0[1]) + (x0[2] * x0[2] + x0[3] * x0[3])) + ((x1[0] * x1[0] + x1[1] * x1[1]) + (x1[2] * x1[2] + x1[3] * x1[3])); } }
                if (xb) { s += __shfl_xor(s, 16); s = sum_xor32(s); if (fq == 0) __hip_atomic_fetch_add(ssq_next + row, s, __ATOMIC_RELAXED, __HIP_MEMORY_SCOPE_AGENT); } }
            asm volatile("" ::: "memory");
        }
    }
};
struct EpiSwiGLU {
    static constexpr bool PERM = true, AFTER_DRAIN = false;
    bf16_t* H; const float* ssq;
    __device__ __forceinline__ void operator()(const f32x4 (&acc)[2][2][4][2], const Unit& u, int wr, int wc, int fr, int fq) const {
        const int row0 = u.pm * BM + wr * 64 + fr, col0 = u.pn * HALF + wc * 32 + 8 * fq;
#pragma unroll
        for (int ai = 0; ai < 2; ++ai)
#pragma unroll
            for (int m = 0; m < 4; ++m) { const int row = row0 + ai * HALF + m * 16; const float rs = rstd_of(ssq, row); bf16_t* rp = H + (size_t)row * 2816 + col0;
                float h[8];
#pragma unroll
                for (int n = 0; n < 2; ++n) { const f32x4 g = acc[ai][0][m][n] * rs, uu = acc[ai][1][m][n] * rs;
#pragma unroll
                    for (int i = 0; i < 4; ++i) h[4 * n + i] = g[i] * uu[i] * __builtin_amdgcn_rcpf(1.0f + __expf(-g[i])); }
                u32x4 w; w.x = cvt_pk_bf16(h[0], h[1]); w.y = cvt_pk_bf16(h[2], h[3]); w.z = cvt_pk_bf16(h[4], h[5]); w.w = cvt_pk_bf16(h[6], h[7]); *(u32x4*)rp = w; }
    }
};

struct EpiQK {
    static constexpr bool PERM = true, AFTER_DRAIN = false;
    bf16_t* O; int ldc; const float* ssq; int q_lo, q_hi, k_hi; const float* qg; const float* kg; const float* rc; const float* rsn; PG8_LAS float* X;
    __device__ __forceinline__ void operator()(const f32x4 (&acc)[2][2][4][2], const Unit& u, int wr, int wc, int fr_in, int fq_in) const {
        int fr = fr_in, fq = fq_in; asm volatile("" : "+v"(fr), "+v"(fq));
        const int row0 = u.pm * BM + wr * 64 + fr, col0 = u.pn * BM + wc * 32 + 8 * fq;
        const bool isq = (u.pn >= q_lo) && (u.pn < q_hi), isk = (u.pn >= q_hi) && (u.pn < k_hi);
        if (!(isq || isk)) {
#pragma unroll
            for (int ai = 0; ai < 2; ++ai)
#pragma unroll
                for (int m = 0; m < 4; ++m) { const int row = row0 + ai * HALF + m * 16; const float rs = rstd_of(ssq, row); bf16_t* rp = O + (size_t)row * ldc + col0;
#pragma unroll
                    for (int bj = 0; bj < 2; ++bj) { const f32x4 v0 = acc[ai][bj][m][0] * rs, v1 = acc[ai][bj][m][1] * rs;
                        u32x4 w; w.x = cvt_pk_bf16(v0[0], v0[1]); w.y = cvt_pk_bf16(v0[2], v0[3]); w.z = cvt_pk_bf16(v1[0], v1[1]); w.w = cvt_pk_bf16(v1[2], v1[3]); *(u32x4*)(rp + bj * HALF) = w; } }
            return;
        }
#pragma unroll
        for (int ai = 0; ai < 2; ++ai)
#pragma unroll
            for (int m = 0; m < 4; ++m) { const int rl = ai * HALF + wr * 64 + m * 16 + fr;
#pragma unroll
                for (int bj = 0; bj < 2; ++bj) { float s = 0.f;
#pragma unroll
                    for (int n = 0; n < 2; ++n) { const f32x4 v = acc[ai][bj][m][n]; s += (v[0] * v[0] + v[1] * v[1]) + (v[2] * v[2] + v[3] * v[3]); }
                    s += __shfl_xor(s, 16); s = sum_xor32(s);
                    if (fq == 0) X[(rl * 2 + bj) * 4 + wc] = s; } }
        asm volatile("s_waitcnt lgkmcnt(0)\n\ts_barrier" ::: "memory");
        const float* g = isq ? qg : kg; const float scale = isq ? (0.125f * 1.4426950408889634f) : 1.0f;
        const f32x4 g0 = *(const f32x4*)(g + 32 * (wc & 1) + 8 * fq), g1 = *(const f32x4*)(g + 32 * (wc & 1) + 8 * fq + 4);
        const bool rot = ((wc & 1) == 0) && (fq < 2);
#pragma unroll
        for (int ai = 0; ai < 2; ++ai)
#pragma unroll
            for (int m = 0; m < 4; ++m) { const int rl = ai * HALF + wr * 64 + m * 16 + fr, row = u.pm * BM + rl; const float rs = rstd_of(ssq, row); bf16_t* rp = O + (size_t)row * ldc + col0;
                const int pos = row & 2047;
                f32x4 c0 = {1.f, 1.f, 1.f, 1.f}, c1 = c0, s0 = {0.f, 0.f, 0.f, 0.f}, s1 = s0;
                if (rot) { c0 = *(const f32x4*)(rc + pos * 8); c1 = *(const f32x4*)(rc + pos * 8 + 4); s0 = *(const f32x4*)(rsn + pos * 8); s1 = *(const f32x4*)(rsn + pos * 8 + 4); if (fq == 0) { s0 = -s0; s1 = -s1; } }
#pragma unroll
                for (int bj = 0; bj < 2; ++bj) { const float hs = (X[(rl * 2 + bj) * 4 + wc] + X[(rl * 2 + bj) * 4 + (wc ^ 1)]) * (rs * rs);
                    const float hr = rsqrtf(hs * (1.0f / 64.0f) + 1e-6f) * rs;
                    f32x4 v0 = acc[ai][bj][m][0] * hr * g0, v1 = acc[ai][bj][m][1] * hr * g1;
                    f32x4 p0, p1;
#pragma unroll
                    for (int i = 0; i < 4; ++i) { p0[i] = other_row16(v0[i], (fq & 1) != 0); p1[i] = other_row16(v1[i], (fq & 1) != 0); }
                    v0 = v0 * c0 + p0 * s0; v1 = v1 * c1 + p1 * s1;
                    v0 = v0 * scale; v1 = v1 * scale;
                    u32x4 w; w.x = cvt_pk_bf16(v0[0], v0[1]); w.y = cvt_pk_bf16(v0[2], v0[3]); w.z = cvt_pk_bf16(v1[0], v1[1]); w.w = cvt_pk_bf16(v1[2], v1[3]);
                    *(u32x4*)(rp + bj * HALF) = w; } }
    }
};

template <class Epi, class Sched, bool ALIGN_EPI = false, bool SP2 = false>
__device__ __forceinline__ void gemm_phase(PG8_LAS unsigned char* lds, const Gemm g, const Sched& S, const Epi& E) {
    const int tid = opaque_tid(), wid = __builtin_amdgcn_readfirstlane(tid >> 6), lane = tid & 63, wr = wid >> 2, wc = wid & 3, fr = lane & 15, fq = lane >> 4;
    const int K = g.K, nt = K / BK;
    unsigned voffA[2], voffB[2];
#pragma unroll
    for (int i = 0; i < 2; ++i) { int R, C; stage_rc(tid * 16 + i * 8192, R, C); const int Rb = Epi::PERM ? ((R & ~31) + perm32(R & 31)) : R;
        voffA[i] = (unsigned)(R * K + C) * 2u; voffB[i] = (unsigned)(Rb * K + C) * 2u; }
    const size_t kstep = (size_t)(BK * 2);
    const size_t hstep = (size_t)HALF * K * 2;
    const size_t tstep = 2 * hstep;
    const unsigned ldsw = (unsigned)wid * 1024u;
    const int aoff = lds_byte(wr * 64 + fr, fq * 8), boff = lds_byte(wc * 32 + fr, fq * 8);
#define PG8_SA(b, h) (((b) * 2 + (h)) * HTB)
#define PG8_SB(b, h) ((4 + (b) * 2 + (h)) * HTB)
#define PG8_STAGE(bufoff, gbase, voff) do { _Pragma("unroll") for (int _i = 0; _i < 2; ++_i) \
        __builtin_amdgcn_global_load_lds((const unsigned*)((const char*)(gbase) + (voff)[_i]), (PG8_LAS unsigned*)(lds + (bufoff) + ldsw + _i * 8192), 16, 0, 0); } while (0)
#define PG8_LDA(dst, b, h) do { _Pragma("unroll") for (int m = 0; m < 4; ++m) _Pragma("unroll") for (int k = 0; k < 2; ++k) dst[m][k] = *(const PG8_LAS bf16x8*)(lds + PG8_SA(b, h) + aoff + m * 2048 + k * 1024); } while (0)
#define PG8_LDB(dst, b, h) do { _Pragma("unroll") for (int n = 0; n < 2; ++n) _Pragma("unroll") for (int k = 0; k < 2; ++k) dst[n][k] = *(const PG8_LAS bf16x8*)(lds + PG8_SB(b, h) + boff + n * 2048 + k * 1024); } while (0)
#define PG8_MMA(ai, bj, At, Bt) do { __builtin_amdgcn_s_setprio(1); _Pragma("unroll") for (int m = 0; m < 4; ++m) _Pragma("unroll") for (int n = 0; n < 2; ++n) _Pragma("unroll") for (int k = 0; k < 2; ++k) \
        acc[ai][bj][m][n] = __builtin_amdgcn_mfma_f32_16x16x32_bf16(Bt[n][k], At[m][k], acc[ai][bj][m][n], 0, 0, 0); __builtin_amdgcn_s_setprio(0); } while (0)
#define PG8_WAIT_V(n) asm volatile("s_waitcnt vmcnt(" #n ")" ::: "memory")
#define PG8_WAIT_L(n) asm volatile("s_waitcnt lgkmcnt(" #n ")" ::: "memory")
#define PG8_BAR __builtin_amdgcn_s_barrier()
#define PG8_SCHED __builtin_amdgcn_sched_barrier(0)
    Unit cur, nxt; int ui = 0;
    if (!S.next(0, cur)) return;
    f32x4 acc[2][2][4][2];
#pragma unroll
    for (int a = 0; a < 2; ++a)
#pragma unroll
        for (int b = 0; b < 2; ++b)
#pragma unroll
            for (int m = 0; m < 4; ++m)
#pragma unroll
                for (int n = 0; n < 2; ++n) acc[a][b][m][n] = (f32x4){0.f, 0.f, 0.f, 0.f};
    bf16x8 At[4][2], B0[2][2], B1[2][2];
    const char* cA = (const char*)g.A + (size_t)cur.pm * tstep; const char* cB = (const char*)g.Bt + (size_t)cur.pn * tstep;
    S.a_ready(cur);
    if constexpr (SP2) {
        PG8_STAGE(PG8_SB(0, 0), cB, voffB); PG8_STAGE(PG8_SB(0, 1), cB + hstep, voffB); PG8_STAGE(PG8_SA(0, 0), cA, voffA); PG8_STAGE(PG8_SA(0, 1), cA + hstep, voffA);
        if (wr == 1) PG8_BAR;
        PG8_WAIT_V(2); PG8_BAR;
        PG8_STAGE(PG8_SB(1, 0), cB + kstep, voffB); PG8_STAGE(PG8_SA(1, 0), cA + kstep, voffA); PG8_STAGE(PG8_SB(1, 1), cB + hstep + kstep, voffB);
        PG8_WAIT_V(6); PG8_BAR;
    } else {
        PG8_STAGE(PG8_SB(0, 0), cB, voffB); PG8_STAGE(PG8_SA(0, 0), cA, voffA); PG8_STAGE(PG8_SB(0, 1), cB + hstep, voffB); PG8_STAGE(PG8_SA(0, 1), cA + hstep, voffA);
        if (wr == 1) PG8_BAR;
        PG8_WAIT_V(4); PG8_BAR;
        PG8_STAGE(PG8_SB(1, 0), cB + kstep, voffB); PG8_STAGE(PG8_SA(1, 0), cA + kstep, voffA); PG8_STAGE(PG8_SB(1, 1), cB + hstep + kstep, voffB);
        PG8_WAIT_V(6); PG8_BAR;
    }
    for (;;) {
        const bool has_next = S.next(ui + 1, nxt);
        const char* nA = has_next ? (const char*)g.A + (size_t)nxt.pm * tstep : cA; const char* nB = has_next ? (const char*)g.Bt + (size_t)nxt.pn * tstep : cB;
        for (int t = 0; t < nt; t += 2) {
            const bool last = (t == nt - 2);
            const char* a1 = cA + (size_t)(t + 1) * kstep;
            const char* a2 = last ? nA : cA + (size_t)(t + 2) * kstep; const char* b2 = last ? nB : cB + (size_t)(t + 2) * kstep;
            const char* a3 = a2 + kstep; const char* b3 = b2 + kstep;
            if (last && has_next) S.a_ready(nxt);
            if constexpr (SP2) {
            PG8_LDB(B0, 0, 0); PG8_LDB(B1, 0, 1); PG8_SCHED; PG8_LDA(At, 0, 0); PG8_STAGE(PG8_SA(1, 1), a1 + hstep, voffA);
            PG8_WAIT_V(8); PG8_WAIT_L(0); PG8_BAR; PG8_MMA(0, 0, At, B0); PG8_MMA(0, 1, At, B1); PG8_BAR; PG8_SCHED;
            PG8_LDA(At, 0, 1); PG8_STAGE(PG8_SB(0, 0), b2, voffB); PG8_STAGE(PG8_SB(0, 1), b2 + hstep, voffB); PG8_STAGE(PG8_SA(0, 0), a2, voffA);
            PG8_WAIT_V(8); PG8_WAIT_L(0); PG8_BAR; PG8_MMA(1, 0, At, B0); PG8_MMA(1, 1, At, B1); PG8_BAR; PG8_SCHED;
            PG8_LDB(B0, 1, 0); PG8_LDB(B1, 1, 1); PG8_SCHED; PG8_LDA(At, 1, 0); PG8_STAGE(PG8_SA(0, 1), a2 + hstep, voffA);
            PG8_WAIT_V(8); PG8_WAIT_L(0); PG8_BAR; PG8_MMA(0, 0, At, B0); PG8_MMA(0, 1, At, B1); PG8_BAR; PG8_SCHED;
            PG8_LDA(At, 1, 1); PG8_STAGE(PG8_SB(1, 0), b3, voffB); PG8_STAGE(PG8_SB(1, 1), b3 + hstep, voffB); PG8_STAGE(PG8_SA(1, 0), a3, voffA);
            PG8_WAIT_V(8); PG8_WAIT_L(0); PG8_BAR; PG8_MMA(1, 0, At, B0); PG8_MMA(1, 1, At, B1); PG8_BAR; PG8_SCHED;
            } else {
            PG8_LDB(B0, 0, 0); PG8_SCHED; PG8_LDA(At, 0, 0); PG8_STAGE(PG8_SA(1, 1), a1 + hstep, voffA);
            PG8_WAIT_L(8); PG8_BAR; PG8_WAIT_L(0); PG8_MMA(0, 0, At, B0); PG8_BAR; PG8_SCHED;
            PG8_LDB(B1, 0, 1); PG8_STAGE(PG8_SB(0, 0), b2, voffB);
            PG8_BAR; PG8_WAIT_L(0); PG8_MMA(0, 1, At, B1); PG8_BAR;
            PG8_LDA(At, 0, 1); PG8_STAGE(PG8_SA(0, 0), a2, voffA);
            PG8_BAR; PG8_WAIT_L(0); PG8_MMA(1, 0, At, B0); PG8_BAR; PG8_SCHED;
            PG8_STAGE(PG8_SB(0, 1), b2 + hstep, voffB);
            PG8_WAIT_V(6); PG8_BAR; PG8_MMA(1, 1, At, B1); PG8_BAR;
            PG8_LDB(B0, 1, 0); PG8_SCHED; PG8_LDA(At, 1, 0); PG8_STAGE(PG8_SA(0, 1), a2 + hstep, voffA);
            PG8_WAIT_L(8); PG8_BAR; PG8_WAIT_L(0); PG8_MMA(0, 0, At, B0); PG8_BAR; PG8_SCHED;
            PG8_LDB(B1, 1, 1); PG8_STAGE(PG8_SB(1, 0), b3, voffB);
            PG8_BAR; PG8_WAIT_L(0); PG8_MMA(0, 1, At, B1); PG8_BAR;
            PG8_LDA(At, 1, 1); PG8_STAGE(PG8_SA(1, 0), a3, voffA);
            PG8_BAR; PG8_WAIT_L(0); PG8_MMA(1, 0, At, B0); PG8_BAR; PG8_SCHED;
            PG8_STAGE(PG8_SB(1, 1), b3 + hstep, voffB);
            PG8_WAIT_V(6); PG8_BAR; PG8_MMA(1, 1, At, B1); PG8_BAR;
            }
        }
        if constexpr (ALIGN_EPI) { if (wr == 0) PG8_BAR; }
        if constexpr (!Epi::AFTER_DRAIN) { E(acc, cur, wr, wc, fr, fq); S.done(cur); }
        if (!has_next) break;
#pragma unroll
        for (int a = 0; a < 2; ++a)
#pragma unroll
            for (int b = 0; b < 2; ++b)
#pragma unroll
                for (int m = 0; m < 4; ++m)
#pragma unroll
                    for (int n = 0; n < 2; ++n) acc[a][b][m][n] = (f32x4){0.f, 0.f, 0.f, 0.f};
        cur = nxt; cA = nA; cB = nB; ++ui;
        if constexpr (ALIGN_EPI) { if (wr == 1) PG8_BAR; }
    }
    PG8_WAIT_V(0);
    if constexpr (!ALIGN_EPI) { if (wr == 0) PG8_BAR; }
    PG8_BAR;
    if constexpr (Epi::AFTER_DRAIN) { E.fused(acc, cur, wr, wc, fr, fq, lds, wid, lane); S.done(cur); }
#undef PG8_SA
#undef PG8_SB
#undef PG8_STAGE
#undef PG8_LDA
#undef PG8_LDB
#undef PG8_MMA
#undef PG8_WAIT_V
#undef PG8_WAIT_L
#undef PG8_BAR
#undef PG8_SCHED
}
}
#define LAS __attribute__((address_space(3)))
typedef unsigned short bf16;
typedef short bf16x8 __attribute__((ext_vector_type(8)));
typedef float f32x4 __attribute__((ext_vector_type(4)));
typedef unsigned u32x4 __attribute__((ext_vector_type(4)));
typedef unsigned u32x2 __attribute__((ext_vector_type(2)));
constexpr int BATCH = 16, SEQ = 2048, DM = 1024, MROWS = BATCH * SEQ, DFF = 2816, NIN = 2560, NQKV = 3072;
constexpr size_t MiB = 1u << 20;
constexpr size_t WS_CTL = 0;
constexpr size_t WS_ROPE = 1 * MiB;
constexpr size_t WS_SSQ = 2 * MiB;
constexpr size_t WS_LSE = 4 * MiB;
constexpr size_t WS_WIN = 16 * MiB, WS_WO0 = 22 * MiB, WS_WGU0 = 24 * MiB, WS_WDN0 = 36 * MiB, WS_WQKV = 42 * MiB, WS_WO1 = 48 * MiB, WS_WGU1 = 50 * MiB, WS_WDN1 = 62 * MiB;
constexpr size_t WS_XB = 68 * MiB;
constexpr size_t WS_A = 132 * MiB;
constexpr size_t WS_B = 324 * MiB;
constexpr size_t WS_C = 388 * MiB;
constexpr size_t WS_END = 452 * MiB;
constexpr int LDS_BYTES = 147456 + 256;
constexpr int LDS_ITEM = 147456;
constexpr int LDS_BARST = 147456 + 64;
constexpr int CW_BAR = 4096;

struct Args { const float* in[27]; float* out; unsigned char* ws; };

__device__ __forceinline__ unsigned cvtpk(float lo, float hi) { typedef float f2 __attribute__((ext_vector_type(2))); typedef __bf16 b2 __attribute__((ext_vector_type(2))); f2 v = {lo, hi}; b2 b = __builtin_convertvector(v, b2); return __builtin_bit_cast(unsigned, b); }
__device__ __forceinline__ float bflo(unsigned u) { return __uint_as_float(u << 16); }
__device__ __forceinline__ float bfhi(unsigned u) { return __uint_as_float(u & 0xffff0000u); }
__device__ __forceinline__ float wave_sum(float v) {
#pragma unroll
    for (int o = 1; o < 64; o <<= 1) v += __shfl_xor(v, o);
    return v;
}
#define LDS_WAIT() asm volatile("s_waitcnt lgkmcnt(0)" ::: "memory")

struct TrItem { const float* W; bf16* WT; const float* gain; int K, N, mode, r; };
__device__ __forceinline__ TrItem tr_decode(const Args& a, int it) {
    constexpr int I_IN = 32 * (NIN / 128), I_O = 32 * 8, I_G = 32 * (DFF / 128), I_D = (DFF / 32) * 8, I_Q = 32 * (NQKV / 128);
    unsigned char* ws = a.ws; int r = it; TrItem d;
    if (r < I_IN) { d = TrItem{a.in[2], (bf16*)(ws + WS_WIN), a.in[1], DM, NIN, 0, r}; return d; } r -= I_IN;
    if (r < I_O) { d = TrItem{a.in[17], (bf16*)(ws + WS_WO0), nullptr, DM, DM, 0, r}; return d; } r -= I_O;
    if (r < I_G) { d = TrItem{a.in[24], (bf16*)(ws + WS_WGU0), a.in[23], DM, DFF, 1, r}; return d; } r -= I_G;
    if (r < I_G) { d = TrItem{a.in[25], (bf16*)(ws + WS_WGU0), a.in[23], DM, DFF, 2, r}; return d; } r -= I_G;
    if (r < I_D) { d = TrItem{a.in[26], (bf16*)(ws + WS_WDN0), nullptr, DFF, DM, 0, r}; return d; } r -= I_D;
    if (r < I_Q) { d = TrItem{a.in[19], (bf16*)(ws + WS_WQKV), a.in[18], DM, NQKV, 0, r}; return d; } r -= I_Q;
    if (r < I_O) { d = TrItem{a.in[22], (bf16*)(ws + WS_WO1), nullptr, DM, DM, 0, r}; return d; } r -= I_O;
    if (r < I_G) { d = TrItem{a.in[24] + (size_t)DM * DFF, (bf16*)(ws + WS_WGU1), a.in[23] + DM, DM, DFF, 1, r}; return d; } r -= I_G;
    if (r < I_G) { d = TrItem{a.in[25] + (size_t)DM * DFF, (bf16*)(ws + WS_WGU1), a.in[23] + DM, DM, DFF, 2, r}; return d; } r -= I_G;
    d = TrItem{a.in[26] + (size_t)DFF * DM, (bf16*)(ws + WS_WDN1), nullptr, DFF, DM, 0, r}; return d;
}
__device__ __forceinline__ void tr_load(const TrItem& d, int lane, f32x4 (&v)[16]) {
    const int nblk = d.N / 128, kb = d.r / nblk, nb = d.r % nblk, k0 = 32 * kb, n0 = 128 * nb;
#pragma unroll
    for (int i = 0; i < 16; ++i) { const int kk = 2 * i + (lane >> 5); v[i] = *(const f32x4*)(d.W + (size_t)(k0 + kk) * d.N + n0 + 4 * (lane & 31)); }
}
__device__ __forceinline__ void tr_store(const TrItem& d, int lane, const f32x4 (&v)[16], LAS float* scr) {
    const int nblk = d.N / 128, kb = d.r / nblk, nb = d.r % nblk, k0 = 32 * kb, n0 = 128 * nb;
#pragma unroll
    for (int i = 0; i < 16; ++i) { const int kk = 2 * i + (lane >> 5); const float gv = d.gain ? d.gain[k0 + kk] : 1.0f; *(LAS f32x4*)(scr + kk * 132 + 4 * (lane & 31)) = v[i] * gv; }
    LDS_WAIT();
    const int rbase = (d.mode == 0) ? n0 : (256 * (n0 >> 7) + (d.mode == 2 ? 128 : 0));
#pragma unroll
    for (int h = 0; h < 2; ++h) { const int n = lane + 64 * h; const LAS float* s = scr + n; u32x4* dst = (u32x4*)(d.WT + (size_t)(rbase + n) * d.K + k0);
#pragma unroll
        for (int q = 0; q < 4; ++q) { u32x4 o; o.x = cvtpk(s[(8 * q + 0) * 132], s[(8 * q + 1) * 132]); o.y = cvtpk(s[(8 * q + 2) * 132], s[(8 * q + 3) * 132]); o.z = cvtpk(s[(8 * q + 4) * 132], s[(8 * q + 5) * 132]); o.w = cvtpk(s[(8 * q + 6) * 132], s[(8 * q + 7) * 132]); dst[q] = o; } }
    LDS_WAIT();
}
__device__ __forceinline__ void p0_prologue(const Args& a, LAS unsigned char* lds) {
    const int tid = opaque_tid(), lane = tid & 63, wave = __builtin_amdgcn_readfirstlane(tid >> 6);
    unsigned char* ws = a.ws;
    LAS float* scr = (LAS float*)(lds + wave * 17408);
    const int gw = blockIdx.x * 8 + wave, NGW = gridDim.x * 8;
    constexpr int NITEMS = 32 * (NIN / 128) + 2 * 32 * 8 + 4 * 32 * (DFF / 128) + 2 * (DFF / 32) * 8 + 32 * (NQKV / 128);
    { f32x4 va[16], vb[16];
      int it = gw; TrItem cur = tr_decode(a, it < NITEMS ? it : 0);
      if (it < NITEMS) tr_load(cur, lane, va);
      while (it < NITEMS) {
          const int i1 = it + NGW; TrItem d1 = cur; if (i1 < NITEMS) { d1 = tr_decode(a, i1); tr_load(d1, lane, vb); }
          tr_store(cur, lane, va, scr);
          if (i1 >= NITEMS) break;
          const int i2 = i1 + NGW; if (i2 < NITEMS) { cur = tr_decode(a, i2); tr_load(cur, lane, va); }
          tr_store(d1, lane, vb, scr);
          it = i2;
      } }
    const float* x = a.in[0]; bf16* xb = (bf16*)(ws + WS_XB); float* ssq = (float*)(ws + WS_SSQ);
    for (int m0 = gw * 4; m0 < MROWS; m0 += NGW * 4) {
        f32x4 v[4][4];
#pragma unroll
        for (int r = 0; r < 4; ++r)
#pragma unroll
            for (int j = 0; j < 4; ++j) v[r][j] = ((const f32x4*)(x + (size_t)(m0 + r) * DM) + lane)[64 * j];
#pragma unroll
        for (int r = 0; r < 4; ++r) { unsigned long long* o8 = (unsigned long long*)(xb + (size_t)(m0 + r) * DM) + lane; float s = 0.f;
#pragma unroll
            for (int j = 0; j < 4; ++j) { const f32x4 q = v[r][j]; s += (q[0] * q[0] + q[1] * q[1]) + (q[2] * q[2] + q[3] * q[3]); o8[64 * j] = (unsigned long long)cvtpk(q[0], q[1]) | ((unsigned long long)cvtpk(q[2], q[3]) << 32); }
            s = wave_sum(s);
            if (lane == 0) ssq[m0 + r] = s; }
    }
    const int gt = blockIdx.x * 512 + tid, NGT = gridDim.x * 512;
    for (int i = gt; i < 3 * MROWS; i += NGT) ssq[MROWS + i] = 0.f;
    for (int i = gt; i < 16384; i += NGT) ((unsigned*)(ws + WS_CTL))[i] = 0u;
    float* rc = (float*)(ws + WS_ROPE); float* rsn = rc + SEQ * 8;
    for (int i = gt; i < SEQ * 8; i += NGT) { const int pos = i >> 3, j = i & 7; const float inv = exp2f(-2.3664460711655217f * (float)j); const float ang = (float)pos * inv; double rev = (double)ang * 0.15915494309189535; rev -= rint(rev); rc[i] = __builtin_amdgcn_cosf((float)rev); rsn[i] = __builtin_amdgcn_sinf((float)rev); }
}
#define XB_TMO      128
#define XB_XCNT(j)  (256  + 64 * (j))
#define XB_XSUB(j)  (1280 + 64 * (j))
#define XB_XGEN(j)  (2304 + 64 * (j))
#define XB_TOP      3328
#define XB_TOPGEN   3392
#define XCD_BAR_WORDS 3456
#define XB_SPIN_CAP (1u << 18)

__device__ __forceinline__ unsigned xb_ld(unsigned* p)              { return __hip_atomic_load(p, __ATOMIC_RELAXED, __HIP_MEMORY_SCOPE_AGENT); }
__device__ __forceinline__ unsigned xb_add(unsigned* p, unsigned v) { return __hip_atomic_fetch_add(p, v, __ATOMIC_RELAXED, __HIP_MEMORY_SCOPE_AGENT); }
__device__ __forceinline__ unsigned xb_xcc_id() { return (unsigned)__builtin_amdgcn_s_getreg((3 << 11) | 20) & 0xFu; }
#define XB_SPIN(cond, bar) do { unsigned _sp = 0; while (cond) { __builtin_amdgcn_s_sleep(1); \
    if ((++_sp & 255u) == 0u) { if (xb_ld(&(bar)[XB_TMO])) break; if (_sp > XB_SPIN_CAP) { atomicAdd(&(bar)[XB_TMO], 1u); break; } } } } while (0)

struct XcdBarrier {
    unsigned* bar; unsigned x;
    volatile LAS unsigned* st;
};

__device__ __forceinline__ XcdBarrier xcd_barrier_post(unsigned* bar, volatile LAS unsigned* st) {
    XcdBarrier b; b.bar = bar; b.x = xb_xcc_id(); b.st = st;
    if (threadIdx.x == 0) (void)xb_add(&bar[XB_XCNT(b.x)], 1u);
    return b;
}
__device__ __forceinline__ void xcd_barrier_complete(unsigned* bar, unsigned x, unsigned& nloc, unsigned& nx) {
    const unsigned G = gridDim.x * gridDim.y * gridDim.z;
    unsigned sum, cnt, mine, sp = 0u;
    for (;;) {
        sum = 0u; cnt = 0u; mine = 0u;
#pragma unroll
        for (unsigned j = 0; j < 16; ++j) { const unsigned c = xb_ld(&bar[XB_XCNT(j)]); sum += c; cnt += (c > 0u) ? 1u : 0u; mine = (j == x) ? c : mine; }
        if (sum == G) break;
        __builtin_amdgcn_s_sleep(1);
        if ((++sp & 255u) == 0u) { if (xb_ld(&bar[XB_TMO])) break; if (sp > XB_SPIN_CAP) { atomicAdd(&bar[XB_TMO], 1u); break; } }
    }
    nloc = mine > 0u ? mine : 1u; nx = cnt > 0u ? cnt : 1u;
}

__device__ __forceinline__ void xcd_barrier(const XcdBarrier& b) {
    asm volatile("s_waitcnt vmcnt(0)" ::: "memory");
    __syncthreads();
    if (threadIdx.x == 0) {
        unsigned* bar = b.bar;
        __builtin_amdgcn_s_waitcnt(0);
        unsigned nloc = b.st[0], nx = b.st[1];
        if (nloc == 0u) { xcd_barrier_complete(bar, b.x, nloc, nx); b.st[0] = nloc; b.st[1] = nx; }
        const unsigned old = xb_add(&bar[XB_XSUB(b.x)], 1u);
        const unsigned gen = old / nloc;
        if (old + 1u == (gen + 1u) * nloc) {
            __builtin_amdgcn_fence(__ATOMIC_RELEASE, "agent");
            asm volatile("s_waitcnt vmcnt(0)" ::: "memory");
            const unsigned og = xb_add(&bar[XB_TOP], 1u);
            const unsigned tg = og / nx;
            if (og + 1u == (tg + 1u) * nx) xb_add(&bar[XB_TOPGEN], 1u);
            else XB_SPIN(xb_ld(&bar[XB_TOPGEN]) == tg, bar);
            __builtin_amdgcn_fence(__ATOMIC_ACQUIRE, "agent");
            xb_add(&bar[XB_XGEN(b.x)], 1u);
            asm volatile("s_waitcnt vmcnt(0)" ::: "memory");
        } else {
            XB_SPIN(xb_ld(&bar[XB_XGEN(b.x)]) == gen, bar);
            __builtin_amdgcn_fence(__ATOMIC_ACQUIRE, "agent");
            asm volatile("s_waitcnt vmcnt(0)" ::: "memory");
        }
    }
    __syncthreads();
}

__device__ __forceinline__ void rglru_unit(LAS unsigned char* lds, const Args& a, int b, int g) {
    const int tid = opaque_tid(), lane = tid & 63, w = __builtin_amdgcn_readfirstlane(tid >> 6), lg = lane >> 4, li = lane & 15;
    LAS bf16* Ub = (LAS bf16*)(lds);
    LAS bf16* Wat = (LAS bf16*)(lds + 18432);
    LAS bf16* Wxt = (LAS bf16*)(lds + 27648);
    constexpr int FP = 68;
    LAS float* Uf = (LAS float*)(lds + 36864);
    LAS float* Af = (LAS float*)(lds + 36864 + 34816);
    LAS float* Bf = (LAS float*)(lds + 36864 + 2 * 34816);
    LAS float* Pap = (LAS float*)(lds + 141312);
    LAS float* Phl = (LAS float*)(lds + 143360);
    LAS float* Car = (LAS float*)(lds + 145408);
    const bf16* proj = (const bf16*)(a.ws + WS_A) + (size_t)b * SEQ * NIN;
    bf16* ycat = (bf16*)(a.ws + WS_B) + (size_t)b * SEQ * DM;
    const float* wa = a.in[5] + (size_t)g * 4096; const float* wx = a.in[7] + (size_t)g * 4096;
#pragma unroll
    for (int e = 0; e < 8; ++e) { const int idx = tid + 512 * e, i = idx >> 6, j = idx & 63; Wat[j * 72 + i] = (bf16)(cvtpk(wa[idx], 0.f) & 0xffffu); Wxt[j * 72 + i] = (bf16)(cvtpk(wx[idx], 0.f) & 0xffffu); }
    if (tid < 64) Car[tid] = 0.f;
    const int c2 = tid & 31, tg = tid >> 5, ch0 = 64 * g + 2 * c2;
    float cw[4][2], cb[2];
#pragma unroll
    for (int j = 0; j < 4; ++j) { cw[j][0] = a.in[3][j * 512 + ch0]; cw[j][1] = a.in[3][j * 512 + ch0 + 1]; }
    cb[0] = a.in[4][ch0]; cb[1] = a.in[4][ch0 + 1];
    float cba[4], cbx[4], csp[4];
#pragma unroll
    for (int nt = 0; nt < 4; ++nt) { const int ch = 64 * g + 16 * nt + li; cba[nt] = a.in[6][ch]; cbx[nt] = a.in[8][ch]; const float lam = a.in[9][ch]; csp[nt] = log1pf(__expf(-lam)); }
    const int sc = lane, ss = w;
    unsigned xwr[11];
#pragma unroll
    for (int i = 0; i < 11; ++i) { const int tok = tg * 8 + i - 3; xwr[i] = tok >= 0 ? *(const unsigned*)(proj + (size_t)tok * NIN + ch0) : 0u; }
    for (int ck = 0; ck < SEQ / 128; ++ck) {
        const int s0 = ck * 128;
        BAR_LDS();
        { float xw[11][2];
#pragma unroll
          for (int i = 0; i < 11; ++i) { xw[i][0] = bflo(xwr[i]); xw[i][1] = bfhi(xwr[i]); }
          if (ck + 1 < SEQ / 128) {
#pragma unroll
              for (int i = 0; i < 11; ++i) xwr[i] = *(const unsigned*)(proj + (size_t)(s0 + 128 + tg * 8 + i - 3) * NIN + ch0); }
#pragma unroll
          for (int i = 0; i < 8; ++i) { float u0 = cb[0], u1 = cb[1];
#pragma unroll
              for (int j = 0; j < 4; ++j) { u0 += cw[j][0] * xw[i + j][0]; u1 += cw[j][1] * xw[i + j][1]; }
              const int t = tg * 8 + i; Uf[t * FP + 2 * c2] = u0; Uf[t * FP + 2 * c2 + 1] = u1; *(LAS unsigned*)(Ub + t * 72 + 2 * c2) = cvtpk(u0, u1); } }
        BAR_LDS();
        f32x4 accR[4], accI[4];
#pragma unroll
        for (int nt = 0; nt < 4; ++nt) { accR[nt] = (f32x4){0.f, 0.f, 0.f, 0.f}; accI[nt] = (f32x4){0.f, 0.f, 0.f, 0.f}; }
#pragma unroll
        for (int ks = 0; ks < 2; ++ks) { const bf16x8 af = *(const LAS bf16x8*)(Ub + (16 * w + li) * 72 + 32 * ks + 8 * lg);
#pragma unroll
            for (int nt = 0; nt < 4; ++nt) { const bf16x8 b1 = *(const LAS bf16x8*)(Wat + (16 * nt + li) * 72 + 32 * ks + 8 * lg), b2 = *(const LAS bf16x8*)(Wxt + (16 * nt + li) * 72 + 32 * ks + 8 * lg);
                accR[nt] = __builtin_amdgcn_mfma_f32_16x16x32_bf16(af, b1, accR[nt], 0, 0, 0); accI[nt] = __builtin_amdgcn_mfma_f32_16x16x32_bf16(af, b2, accI[nt], 0, 0, 0); } }
#pragma unroll
        for (int nt = 0; nt < 4; ++nt)
#pragma unroll
            for (int i = 0; i < 4; ++i) { const int t = 16 * w + 4 * lg + i, c = 16 * nt + li;
                const float r = __builtin_amdgcn_rcpf(1.0f + __expf(-(accR[nt][i] + cba[nt]))), ig = __builtin_amdgcn_rcpf(1.0f + __expf(-(accI[nt][i] + cbx[nt])));
                const float la = -8.0f * r * csp[nt]; const float av = __expf(la); const float bv = __builtin_amdgcn_sqrtf(fmaxf(fmaf(-av, av, 1.0f), 0.f)) * (ig * Uf[t * FP + c]);
                Af[t * FP + c] = av; Bf[t * FP + c] = bv; }
        unsigned short gv[16];
#pragma unroll
        for (int i = 0; i < 16; ++i) gv[i] = proj[(size_t)(s0 + 16 * ss + i) * NIN + 512 + 64 * g + sc];
        BAR_LDS();
        float hl[16], ap[16]; { float h = 0.f, p = 1.f;
#pragma unroll
          for (int i = 0; i < 16; ++i) { const float av = Af[(16 * ss + i) * FP + sc], bv = Bf[(16 * ss + i) * FP + sc]; h = av * h + bv; p *= av; hl[i] = h; ap[i] = p; }
          Pap[ss * 64 + sc] = p; Phl[ss * 64 + sc] = h; }
        BAR_LDS();
        float hin = Car[(ck & 1) * 64 + sc];
        for (int j = 0; j < ss; ++j) hin = Pap[j * 64 + sc] * hin + Phl[j * 64 + sc];
#pragma unroll
        for (int i = 0; i < 16; ++i) { const float h = hl[i] + ap[i] * hin; const float x = bflo(gv[i]); const float z = 0.7978845608028654f * (x + 0.044715f * x * x * x);
            const float ge = x * __builtin_amdgcn_rcpf(1.0f + __expf(-2.0f * z)); ycat[(size_t)(s0 + 16 * ss + i) * DM + 64 * g + sc] = (bf16)(cvtpk(h * ge, 0.f) & 0xffffu);
            if (i == 15 && ss == 7) Car[((ck + 1) & 1) * 64 + sc] = h; }
    }
    BAR_LDS();
}
typedef short v4i16_t __attribute__((ext_vector_type(4)));
__device__ __forceinline__ u32x2 tr_read4(const LAS bf16* p) { return __builtin_bit_cast(u32x2, __builtin_amdgcn_ds_read_tr16_b64_v4i16((LAS v4i16_t*)p)); }
__device__ __forceinline__ float score_bound(const float* qg, const float* kg, int lane) {
    float a = fabsf(qg[lane]), b = fabsf(kg[lane]);
#pragma unroll
    for (int o = 1; o < 64; o <<= 1) { a = fmaxf(a, __shfl_xor(a, o)); b = fmaxf(b, __shfl_xor(b, o)); }
    return 8.0f * 1.4426950408889634f * a * b * 1.01f + 0.5f;
}
struct AttnArgs {
    const bf16* Q; const bf16* K; const bf16* V; int ld;
    int qc0, T1;
    bf16* O; int ldo; float lam; const float* subg; float mb;
};
__device__ __forceinline__ void diff_unit(LAS unsigned char* lds, const AttnArgs A) {
    constexpr int NC = 2, DV = 128, QP = NC * 64 + 8, VP = DV + 16, NDT = DV / 16, NVH = DV / 64;
    const int tid = opaque_tid(), lane = tid & 63, w = __builtin_amdgcn_readfirstlane(tid >> 6), lg = lane >> 4, li = lane & 15;
    constexpr int TBUF = 64 * QP + 64 * VP;
    const int krow = tid >> 3, c8 = tid & 7;
    u32x4 kraw[NC], vraw[NVH];
#define ATT_LOAD(T) do { const int tk_ = 64 * (T) + krow; \
        _Pragma("unroll") for (int c = 0; c < NC; ++c) kraw[c] = *(const u32x4*)(A.K + (size_t)tk_ * A.ld + c * 64 + 8 * c8); \
        _Pragma("unroll") for (int hh = 0; hh < NVH; ++hh) vraw[hh] = *(const u32x4*)(A.V + (size_t)tk_ * A.ld + hh * 64 + 8 * c8); } while (0)
#define ATT_WRITE(buf) do { LAS bf16* Ks_ = (LAS bf16*)lds + (buf) * TBUF; LAS bf16* Vs_ = Ks_ + 64 * QP; \
        _Pragma("unroll") for (int c = 0; c < NC; ++c) *(LAS u32x4*)(Ks_ + krow * QP + c * 64 + 8 * c8) = kraw[c]; \
        _Pragma("unroll") for (int hh = 0; hh < NVH; ++hh) *(LAS u32x4*)(Vs_ + krow * VP + hh * 64 + 8 * c8) = vraw[hh]; } while (0)
    ATT_LOAD(0);
    const int qw = A.qc0 + 16 * w, qc = qw + li;
    bf16x8 qf[NC][2];
#pragma unroll
    for (int c = 0; c < NC; ++c)
#pragma unroll
        for (int ks = 0; ks < 2; ++ks) qf[c][ks] = *(const bf16x8*)(A.Q + (size_t)qc * A.ld + c * 64 + 32 * ks + 8 * lg);
    float lrun[NC]; f32x4 O[NC][NDT];
#pragma unroll
    for (int c = 0; c < NC; ++c) { lrun[c] = 0.f;
#pragma unroll
        for (int dt = 0; dt < NDT; ++dt) O[c][dt] = (f32x4){0.f, 0.f, 0.f, 0.f}; }
    const float nmb = -A.mb;
    BAR_LDS();
    ATT_WRITE(0);
    if (1 < A.T1) ATT_LOAD(1);
    BAR_LDS();
    for (int T = 0; T < A.T1; ++T) {
        const LAS bf16* Ks = (const LAS bf16*)lds + (T & 1) * TBUF; const LAS bf16* Vs = Ks + 64 * QP;
        const int k0 = 64 * T;
        if (k0 <= qw + 15) {
            const bool domask = (k0 + 63 > qw);
            bf16x8 pf[NC][2];
#pragma unroll
            for (int c = 0; c < NC; ++c) {
                f32x4 s[4];
#pragma unroll
                for (int nt = 0; nt < 4; ++nt) { s[nt] = (f32x4){nmb, nmb, nmb, nmb};
#pragma unroll
                    for (int ks = 0; ks < 2; ++ks) { const bf16x8 kf = *(const LAS bf16x8*)(Ks + (16 * nt + li) * QP + c * 64 + 32 * ks + 8 * lg); s[nt] = __builtin_amdgcn_mfma_f32_16x16x32_bf16(kf, qf[c][ks], s[nt], 0, 0, 0); } }
                if (domask) {
#pragma unroll
                    for (int nt = 0; nt < 4; ++nt)
#pragma unroll
                        for (int i = 0; i < 4; ++i) { const int kc = k0 + 16 * nt + 4 * lg + i; if (kc > qc) s[nt][i] = -1e30f; }
                }
                float lsum = 0.f;
#pragma unroll
                for (int nt = 0; nt < 4; ++nt)
#pragma unroll
                    for (int i = 0; i < 4; ++i) { const float p = __builtin_amdgcn_exp2f(s[nt][i]); s[nt][i] = p; lsum += p; }
                lrun[c] += lsum;
#pragma unroll
                for (int kp = 0; kp < 2; ++kp) { u32x4 pk; pk.x = cvtpk(s[2 * kp][0], s[2 * kp][1]); pk.y = cvtpk(s[2 * kp][2], s[2 * kp][3]); pk.z = cvtpk(s[2 * kp + 1][0], s[2 * kp + 1][1]); pk.w = cvtpk(s[2 * kp + 1][2], s[2 * kp + 1][3]); pf[c][kp] = __builtin_bit_cast(bf16x8, pk); }
            }
#pragma unroll
            for (int dt = 0; dt < NDT; ++dt)
#pragma unroll
                for (int kp = 0; kp < 2; ++kp) { const u32x2 lo = tr_read4(Vs + (32 * kp + 4 * lg + (li >> 2)) * VP + 16 * dt + 4 * (li & 3)), hi = tr_read4(Vs + (32 * kp + 16 + 4 * lg + (li >> 2)) * VP + 16 * dt + 4 * (li & 3));
                    u32x4 vv; vv.x = lo.x; vv.y = lo.y; vv.z = hi.x; vv.w = hi.y; const bf16x8 vf = __builtin_bit_cast(bf16x8, vv);
#pragma unroll
                    for (int c = 0; c < NC; ++c) O[c][dt] = __builtin_amdgcn_mfma_f32_16x16x32_bf16(vf, pf[c][kp], O[c][dt], 0, 0, 0); }
        }
        if (T + 1 < A.T1) { ATT_WRITE((T + 1) & 1); if (T + 2 < A.T1) ATT_LOAD(T + 2); }
        BAR_LDS();
    }
#undef ATT_LOAD
#undef ATT_WRITE
    float lt[NC];
#pragma unroll
    for (int c = 0; c < NC; ++c) { float l = lrun[c]; l += __shfl_xor(l, 16); l += __shfl_xor(l, 32); lt[c] = l; }
    const float i0 = 1.0f / lt[0], i1 = A.lam / lt[1]; float ssq = 0.f;
#pragma unroll
    for (int dt = 0; dt < NDT; ++dt) { O[0][dt] = O[0][dt] * i0 - O[1][dt] * i1; ssq += (O[0][dt][0] * O[0][dt][0] + O[0][dt][1] * O[0][dt][1]) + (O[0][dt][2] * O[0][dt][2] + O[0][dt][3] * O[0][dt][3]); }
    ssq += __shfl_xor(ssq, 16); ssq += __shfl_xor(ssq, 32);
    const float rs = rsqrtf(ssq * (1.0f / (float)DV) + 1e-6f) * 0.8f;
#pragma unroll
    for (int dt = 0; dt < NDT; ++dt) { const f32x4 gg = *(const f32x4*)(A.subg + 16 * dt + 4 * lg); const f32x4 o = O[0][dt] * gg * rs; u32x2 wv; wv.x = cvtpk(o[0], o[1]); wv.y = cvtpk(o[2], o[3]); *(u32x2*)(A.O + (size_t)qc * A.ldo + 16 * dt + 4 * lg) = wv; }
}

struct DilUnit { const bf16* Q; const bf16* K; const bf16* V; bf16* O; float* lse; int dil, r, n, kbeg, nk; };
__device__ __forceinline__ bf16* op_buf(unsigned char* ws, int p) { return (bf16*)(ws + (p == 0 ? WS_B : (p == 1 ? WS_XB : WS_C))); }
__device__ __forceinline__ DilUnit dil_decode(const Args& a, int i, int G) {
    const int it = blockIdx.x + i * G; const int u = it % 48, bh = it / 48;
    const int b = bh >> 4, h = bh & 15;
    int p, dil, r, n;
    if (u < 16) { p = 0; dil = 1; r = 0; n = u; } else if (u < 32) { p = 1; dil = 4; r = (u - 16) >> 2; n = (u - 16) & 3; } else { p = 2; dil = 16; r = u - 32; n = 0; }
    const bf16* qkv = (const bf16*)(a.ws + WS_A) + (size_t)b * SEQ * NQKV + 64 * h;
    DilUnit U; U.Q = qkv; U.K = qkv + 1024; U.V = qkv + 2048; U.O = op_buf(a.ws, p) + (size_t)b * SEQ * DM + 64 * h;
    U.lse = (float*)(a.ws + WS_LSE) + (size_t)p * MROWS * 16 + (size_t)b * SEQ * 16 + h; U.dil = dil; U.r = r; U.n = n; U.kbeg = n > 0 ? 128 * (n - 1) : 0; U.nk = n > 0 ? 256 : 128;
    return U;
}
template <bool PREV>
__device__ __forceinline__ void dil_compute(const LAS bf16* Ks, const LAS bf16* Vs, bf16x8 qf0, bf16x8 qf1, int w, int lg, int li, float mb, f32x4 (&O)[4], float& lsum_out) {
    constexpr int KP = 72, NS = PREV ? 9 : 8, NPAIR = PREV ? 5 : 4;
    const int st0 = PREV ? w : 0;
    f32x4 s[10];
    {
        bf16x8 kA[NS], kB[NS];
#pragma unroll
        for (int j = 0; j < NS; ++j) { const int st = st0 + j; kA[j] = *(const LAS bf16x8*)(Ks + (16 * st + li) * KP + 8 * lg); kB[j] = *(const LAS bf16x8*)(Ks + (16 * st + li) * KP + 32 + 8 * lg); }
        __builtin_amdgcn_sched_barrier(0);
        const f32x4 zc = {-mb, -mb, -mb, -mb};
#pragma unroll
        for (int j = 0; j < NS; ++j) s[j] = __builtin_amdgcn_mfma_f32_16x16x32_bf16(kA[j], qf0, zc, 0, 0, 0);
#pragma unroll
        for (int j = 0; j < NS; ++j) s[j] = __builtin_amdgcn_mfma_f32_16x16x32_bf16(kB[j], qf1, s[j], 0, 0, 0);
    }
    u32x2 vlo[NPAIR][4], vhi[NPAIR][4];
#pragma unroll
    for (int kp = 0; kp < NPAIR; ++kp) { const int sa = st0 + 2 * kp; int sb = sa + 1; if (PREV && sb > 15) sb = 15;
#pragma unroll
        for (int dt = 0; dt < 4; ++dt) { vlo[kp][dt] = tr_read4(Vs + (16 * sa + 4 * lg + (li >> 2)) * KP + 16 * dt + 4 * (li & 3)); vhi[kp][dt] = tr_read4(Vs + (16 * sb + 4 * lg + (li >> 2)) * KP + 16 * dt + 4 * (li & 3)); } }
    __builtin_amdgcn_sched_barrier(0);
    if (PREV) {
#pragma unroll
        for (int e = 0; e < 4; ++e) { if (li > 4 * lg + e) s[0][e] = -1e30f; if (4 * lg + e > li) s[8][e] = -1e30f; }
    } else {
        const int qrel = 16 * w + li;
#pragma unroll
        for (int j = 0; j < NS; ++j)
#pragma unroll
            for (int e = 0; e < 4; ++e) if (16 * j + 4 * lg + e > qrel) s[j][e] = -1e30f;
    }
    float lsum = 0.f;
#pragma unroll
    for (int j = 0; j < NS; ++j)
#pragma unroll
        for (int e = 0; e < 4; ++e) { const float p = __builtin_amdgcn_exp2f(s[j][e]); s[j][e] = p; lsum += p; }
#pragma unroll
    for (int j = NS; j < 10; ++j) s[j] = (f32x4){0.f, 0.f, 0.f, 0.f};
#pragma unroll
    for (int dt = 0; dt < 4; ++dt) O[dt] = (f32x4){0.f, 0.f, 0.f, 0.f};
#pragma unroll
    for (int kp = 0; kp < NPAIR; ++kp) {
        u32x4 pk; pk.x = cvtpk(s[2 * kp][0], s[2 * kp][1]); pk.y = cvtpk(s[2 * kp][2], s[2 * kp][3]); pk.z = cvtpk(s[2 * kp + 1][0], s[2 * kp + 1][1]); pk.w = cvtpk(s[2 * kp + 1][2], s[2 * kp + 1][3]);
        const bf16x8 pf = __builtin_bit_cast(bf16x8, pk);
#pragma unroll
        for (int dt = 0; dt < 4; ++dt) { u32x4 vv; vv.x = vlo[kp][dt].x; vv.y = vlo[kp][dt].y; vv.z = vhi[kp][dt].x; vv.w = vhi[kp][dt].y; O[dt] = __builtin_amdgcn_mfma_f32_16x16x32_bf16(__builtin_bit_cast(bf16x8, vv), pf, O[dt], 0, 0, 0); }
    }
    lsum += __shfl_xor(lsum, 16); lsum = pg8::sum_xor32(lsum);
    lsum_out = lsum;
}
__device__ __forceinline__ void dil_store(const f32x4 (&O)[4], float lsum, float mb, int lg, bf16* Orow, float* lsep) {
    const float inv = 1.0f / lsum;
#pragma unroll
    for (int dt = 0; dt < 4; ++dt) { const f32x4 o = O[dt] * inv; u32x2 wv; wv.x = cvtpk(o[0], o[1]); wv.y = cvtpk(o[2], o[3]); *(u32x2*)(Orow + 16 * dt + 4 * lg) = wv; }
    if (lg == 0) *lsep = (mb + __log2f(lsum)) * 0.6931471805599453f;
}
__device__ __forceinline__ void p7_dilated(const Args& a, LAS unsigned char* lds) {
    constexpr int KP = 72, KBYTES = 256 * KP * 2, BUF = 2 * KBYTES, NTOT = BATCH * 16 * 48;
    const int tid = opaque_tid(), lane = tid & 63, w = __builtin_amdgcn_readfirstlane(tid >> 6), lg = lane >> 4, li = lane & 15, krow = tid >> 3, c8 = tid & 7;
    const int G = gridDim.x;
    const float mb = score_bound(a.in[20], a.in[21], lane);
    const int nun = (NTOT - (int)blockIdx.x + G - 1) / G;
    u32x4 kr[4], vr[4]; bf16x8 qn[2];
    DilUnit U = dil_decode(a, 0, G);
#define DIL_LOAD() do { \
        _Pragma("unroll") for (int j = 0; j < 4; ++j) if (64 * j < U.nk) { \
            kr[j] = *(const u32x4*)(U.K + (size_t)((U.kbeg + krow + 64 * j) * U.dil + U.r) * NQKV + 8 * c8); \
            vr[j] = *(const u32x4*)(U.V + (size_t)((U.kbeg + krow + 64 * j) * U.dil + U.r) * NQKV + 8 * c8); } \
        _Pragma("unroll") for (int ks = 0; ks < 2; ++ks) qn[ks] = *(const bf16x8*)(U.Q + (size_t)((128 * U.n + 16 * w + li) * U.dil + U.r) * NQKV + 32 * ks + 8 * lg); } while (0)
#define DIL_WRITE(buf) do { LAS bf16* Ks_ = (LAS bf16*)(lds + (buf) * BUF); LAS bf16* Vs_ = (LAS bf16*)(lds + (buf) * BUF + KBYTES); \
        _Pragma("unroll") for (int j = 0; j < 4; ++j) if (64 * j < U.nk) { \
            *(LAS u32x4*)(Ks_ + (krow + 64 * j) * KP + 8 * c8) = kr[j]; *(LAS u32x4*)(Vs_ + (krow + 64 * j) * KP + 8 * c8) = vr[j]; } } while (0)
    BAR_LDS();
    if (nun > 0) { DIL_LOAD(); DIL_WRITE(0); }
    BAR_LDS();
    DilUnit C = U; bf16x8 qf0 = qn[0], qf1 = qn[1];
    for (int i = 0; i < nun; ++i) {
        const bool more = i + 1 < nun;
        if (more) { U = dil_decode(a, i + 1, G); DIL_LOAD(); }
        const LAS bf16* Ks = (const LAS bf16*)(lds + (i & 1) * BUF); const LAS bf16* Vs = (const LAS bf16*)(lds + (i & 1) * BUF + KBYTES);
        f32x4 O[4]; float lsum;
        if (C.n > 0) dil_compute<true>(Ks, Vs, qf0, qf1, w, lg, li, mb, O, lsum);
        else dil_compute<false>(Ks, Vs, qf0, qf1, w, lg, li, mb, O, lsum);
        const int tokq = (128 * C.n + 16 * w + li) * C.dil + C.r; bf16* Orow = C.O + (size_t)tokq * DM; float* lsep = C.lse + (size_t)tokq * 16;
        if (more) { DIL_WRITE((i + 1) & 1); qf0 = qn[0]; qf1 = qn[1]; C = U; }
        asm volatile("" :: "v"(qf0), "v"(qf1));
        dil_store(O, lsum, mb, lg, Orow, lsep);
        BAR_LDS();
    }
#undef DIL_LOAD
#undef DIL_WRITE
}
__device__ __forceinline__ int next_item(LAS unsigned char* lds, unsigned* ctr) {
    LAS int* slot = (LAS int*)(lds + LDS_ITEM);
    __syncthreads();
    if (threadIdx.x == 0) *slot = (int)__hip_atomic_fetch_add(ctr, 1u, __ATOMIC_RELAXED, __HIP_MEMORY_SCOPE_AGENT);
    __syncthreads();
    return *slot;
}
__device__ __forceinline__ void p2_mixers(const Args& a, LAS unsigned char* lds, int coff) {
    const int lane = opaque_tid() & 63;
    float lam; { const float d1 = wave_sum(a.in[12][lane] * a.in[13][lane]), d2 = wave_sum(a.in[14][lane] * a.in[15][lane]); lam = __expf(d1) - __expf(d2) + 0.2f; }
    unsigned* ctr = (unsigned*)(a.ws + WS_CTL) + coff;
    const float mb = score_bound(a.in[10], a.in[11], lane);
    constexpr int NATT = BATCH * 4 * 16;
#ifndef NO_RGLRU
    for (;;) {
        const int it = next_item(lds, ctr);
        if (it >= 128) break;
        rglru_unit(lds, a, it >> 3, it & 7);
    }
#if PROBE == 20
    for (;;) {
        const int it = next_item(lds, ctr + 16);
        if (it >= 128) break;
        rglru_unit(lds, a, it >> 3, it & 7);
    }
#endif
#endif
#ifndef NO_DIFF
    {
        LAS int* slot = (LAS int*)(lds + LDS_ITEM);
        int j = next_item(lds, ctr + 2);
        while (j < NATT) {
            unsigned nxt = 0u; if (threadIdx.x == 0) nxt = __hip_atomic_fetch_add(ctr + 2, 1u, __ATOMIC_RELAXED, __HIP_MEMORY_SCOPE_AGENT);
            const int qb = 15 - (j >> 6), bh = j & 63, b = bh >> 2, h = bh & 3;
            const bf16* proj = (const bf16*)(a.ws + WS_A) + (size_t)b * SEQ * NIN;
            AttnArgs A; A.Q = proj + 1024 + 128 * h; A.K = proj + 1536 + 128 * h; A.V = proj + 2048 + 128 * h; A.ld = NIN;
            A.qc0 = 128 * qb; A.T1 = 2 * qb + 2;
            A.O = (bf16*)(a.ws + WS_B) + (size_t)b * SEQ * DM + 512 + 128 * h; A.ldo = DM; A.lam = lam; A.subg = a.in[16]; A.mb = mb;
            diff_unit(lds, A);
            if (threadIdx.x == 0) *slot = (int)nxt;
            BAR_LDS();
            j = *slot;
        }
    }
#endif
}
__device__ __forceinline__ void p7b_merge(const Args& a) {
    const int gt = blockIdx.x * 512 + opaque_tid(), NGT = gridDim.x * 512;
    const float* lse = (const float*)(a.ws + WS_LSE);
    bf16* o0 = op_buf(a.ws, 0); const bf16* o1 = op_buf(a.ws, 1); const bf16* o2 = op_buf(a.ws, 2);
    for (int i0 = gt; i0 < MROWS * 128; i0 += 4 * NGT) {
        float l0[4], l1[4], l2[4]; u32x4 v0[4], v1[4], v2[4];
#pragma unroll
        for (int k = 0; k < 4; ++k) { const int i = i0 + k * NGT; const int row = i >> 7, hc = i & 127, h = hc >> 3; const size_t off = (size_t)row * DM + 8 * hc;
            l0[k] = lse[(size_t)row * 16 + h]; l1[k] = lse[(size_t)MROWS * 16 + (size_t)row * 16 + h]; l2[k] = lse[(size_t)2 * MROWS * 16 + (size_t)row * 16 + h];
            v0[k] = *(const u32x4*)(o0 + off); v1[k] = *(const u32x4*)(o1 + off); v2[k] = *(const u32x4*)(o2 + off); }
#pragma unroll
        for (int k = 0; k < 4; ++k) { const int i = i0 + k * NGT; const int row = i >> 7, hc = i & 127; const size_t off = (size_t)row * DM + 8 * hc;
            const float mx = fmaxf(l0[k], fmaxf(l1[k], l2[k])); float e0 = __expf(l0[k] - mx), e1 = __expf(l1[k] - mx), e2 = __expf(l2[k] - mx); const float inv = 1.0f / (e0 + e1 + e2); e0 *= inv; e1 *= inv; e2 *= inv;
            u32x4 o;
            o.x = cvtpk(e0 * bflo(v0[k].x) + e1 * bflo(v1[k].x) + e2 * bflo(v2[k].x), e0 * bfhi(v0[k].x) + e1 * bfhi(v1[k].x) + e2 * bfhi(v2[k].x));
            o.y = cvtpk(e0 * bflo(v0[k].y) + e1 * bflo(v1[k].y) + e2 * bflo(v2[k].y), e0 * bfhi(v0[k].y) + e1 * bfhi(v1[k].y) + e2 * bfhi(v2[k].y));
            o.z = cvtpk(e0 * bflo(v0[k].z) + e1 * bflo(v1[k].z) + e2 * bflo(v2[k].z), e0 * bfhi(v0[k].z) + e1 * bfhi(v1[k].z) + e2 * bfhi(v2[k].z));
            o.w = cvtpk(e0 * bflo(v0[k].w) + e1 * bflo(v1[k].w) + e2 * bflo(v2[k].w), e0 * bfhi(v0[k].w) + e1 * bfhi(v1[k].w) + e2 * bfhi(v2[k].w));
            *(u32x4*)(o0 + off) = o; }
    }
}

template <class Epi> __device__ __forceinline__ void run_gemm(LAS unsigned char* lds, const bf16* A, const bf16* Bt, int N, int K, const Epi& E) {
    pg8::Gemm g{A, Bt, MROWS, N, K}; pg8::StaticOrder S; S.init(MROWS, N, (int)gridDim.x, (int)blockIdx.x);
    pg8::gemm_phase<Epi, pg8::StaticOrder, true, true>(lds, g, S, E);
}
#ifndef PHMASK
#define PHMASK 0xfff
#endif
#ifndef PROBE
#define PROBE -1
#endif
#define REP(n) for (int rep = 0; rep < 1; ++rep)
#if PROBE == 30
#define GSYNC() do { xcd_barrier(xbar); xcd_barrier(xbar); } while (0)
#else
#define GSYNC() xcd_barrier(xbar)
#endif
#define DUP(n, ...) do { if ((PROBE) == (n)) { __VA_ARGS__; } } while (0)
__global__ void __launch_bounds__(512) fwd_megakernel(Args a) {
    extern __shared__ __attribute__((aligned(16))) unsigned char lds_raw[];
    LAS unsigned char* lds = (LAS unsigned char*)lds_raw;
    cg::grid_group grid = cg::this_grid();
    unsigned char* ws = a.ws;
    float* ssq = (float*)(ws + WS_SSQ); const float* ropec = (const float*)(ws + WS_ROPE);
    bf16* xb = (bf16*)(ws + WS_XB); bf16* bufA = (bf16*)(ws + WS_A); bf16* bufB = (bf16*)(ws + WS_B);
    REP(0) { p0_prologue(a, lds); } DUP(0, p0_prologue(a, lds));
    if (threadIdx.x < 2) ((LAS unsigned*)(lds + LDS_BARST))[threadIdx.x] = 0u;
    grid.sync();
    const XcdBarrier xbar = xcd_barrier_post((unsigned*)(ws + WS_CTL) + CW_BAR, (volatile LAS unsigned*)(lds + LDS_BARST));
    REP(1) { run_gemm(lds, xb, (const bf16*)(ws + WS_WIN), NIN, DM, pg8::EpiQK{bufA, NIN, ssq, 4, 6, 8, a.in[10], a.in[11], ropec, ropec + SEQ * 8, (LAS float*)(lds + 131072)}); }
    GSYNC();
    REP(2) { p2_mixers(a, lds, 0); } DUP(2, p2_mixers(a, lds, 8));
    GSYNC();
    { run_gemm(lds, bufB, (const bf16*)(ws + WS_WO0), DM, DM, pg8::EpiResid{a.in[0], a.out, xb, ssq + MROWS}); }
    DUP(3, run_gemm(lds, bufB, (const bf16*)(ws + WS_WO0), DM, DM, pg8::EpiScale{bufA, DM, ssq}));
    GSYNC();
    REP(4) { run_gemm(lds, xb, (const bf16*)(ws + WS_WGU0), 2 * DFF, DM, pg8::EpiSwiGLU{bufA, ssq + MROWS}); } DUP(4, run_gemm(lds, xb, (const bf16*)(ws + WS_WGU0), 2 * DFF, DM, pg8::EpiSwiGLU{bufA, ssq + MROWS}));
    GSYNC();
    { run_gemm(lds, bufA, (const bf16*)(ws + WS_WDN0), DM, DFF, pg8::EpiResid{a.out, a.out, xb, ssq + 2 * MROWS}); }
    DUP(5, run_gemm(lds, bufA, (const bf16*)(ws + WS_WDN0), DM, DFF, pg8::EpiScale{bufB, DM, ssq}));
    GSYNC();
    REP(6) { run_gemm(lds, xb, (const bf16*)(ws + WS_WQKV), NQKV, DM, pg8::EpiQK{bufA, NQKV, ssq + 2 * MROWS, 0, 4, 8, a.in[20], a.in[21], ropec, ropec + SEQ * 8, (LAS float*)(lds + 131072)}); }
    GSYNC();
    REP(7) { p7_dilated(a, lds); } DUP(7, p7_dilated(a, lds));
    GSYNC();
    p7b_merge(a);
    GSYNC();
    { run_gemm(lds, bufB, (const bf16*)(ws + WS_WO1), DM, DM, pg8::EpiResid{a.out, a.out, xb, ssq + 3 * MROWS}); }
    GSYNC();
    REP(10) { run_gemm(lds, xb, (const bf16*)(ws + WS_WGU1), 2 * DFF, DM, pg8::EpiSwiGLU{bufA, ssq + 3 * MROWS}); }
    GSYNC();
    { run_gemm(lds, bufA, (const bf16*)(ws + WS_WDN1), DM, DFF, pg8::EpiResid{a.out, a.out, nullptr, nullptr}); }
}

extern "C" void kernel_launch(void* const* d_in, const int* in_sizes, int n_in, void* d_out, int out_size, void* d_ws, size_t ws_size, hipStream_t stream) {
    static int grid = 0;
    if (grid == 0) {
        if (n_in != 27 || out_size != MROWS * DM || ws_size < WS_END) { fprintf(stderr, "kernel_launch: unexpected shapes (n_in %d, out %d, ws %zu)\n", n_in, out_size, ws_size); grid = -1; return; }
        int dev = 0, cus = 0, per_cu = 0;
        hipGetDevice(&dev); hipDeviceGetAttribute(&cus, hipDeviceAttributeMultiprocessorCount, dev);
        if (hipFuncSetAttribute((const void*)fwd_megakernel, hipFuncAttributeMaxDynamicSharedMemorySize, LDS_BYTES) != hipSuccess) { fprintf(stderr, "kernel_launch: hipFuncSetAttribute failed\n"); grid = -1; return; }
        if (hipOccupancyMaxActiveBlocksPerMultiprocessor(&per_cu, (const void*)fwd_megakernel, 512, LDS_BYTES) != hipSuccess || per_cu < 1) { fprintf(stderr, "kernel_launch: occupancy query failed (%d)\n", per_cu); (void)hipGetLastError(); per_cu = 1; }
        grid = cus * (per_cu > 1 ? 1 : per_cu);
        fprintf(stderr, "kernel_launch: grid %d (cus %d, per_cu %d)\n", grid, cus, per_cu);
    }
    if (grid < 0) return;
    Args a{};
    for (int i = 0; i < 27; ++i) a.in[i] = (const float*)d_in[i];
    a.out = (float*)d_out; a.ws = (unsigned char*)d_ws;
    void* args[] = {&a};
    hipError_t e = hipLaunchCooperativeKernel((const void*)fwd_megakernel, dim3(grid), dim3(512), args, LDS_BYTES, stream);
    if (e != hipSuccess) fprintf(stderr, "kernel_launch: cooperative launch failed: %s (grid %d)\n", hipGetErrorString(e), grid);
}
```

```cpp
#include <hip/hip_runtime.h>
#include <hip/hip_cooperative_groups.h>
#include <cstdio>
#include <cstdint>
namespace cg = cooperative_groups;
__device__ __forceinline__ int opaque_tid() { int t = threadIdx.x; asm volatile("" : "+v"(t)); return t; }
#define BAR_LDS() asm volatile("s_waitcnt lgkmcnt(0)\n\ts_barrier" ::: "memory")
namespace pg8 {
#define PG8_LAS __attribute__((address_space(3)))
typedef unsigned short bf16_t;
typedef short bf16x8 __attribute__((ext_vector_type(8)));
typedef float f32x4 __attribute__((ext_vector_type(4)));
typedef unsigned u32x4 __attribute__((ext_vector_type(4)));
constexpr int BM = 256, BK = 64, HALF = 128, HTB = HALF * BK * 2  , STAGE_BYTES = 8 * HTB, NXCD = 8, WGM = 4;

__host__ __device__ __forceinline__ int lds_byte(int r, int c) { const int st = (r >> 4) * 2 + (c >> 5), rr = r & 15, cc = c & 31, ob = rr * 64 + cc * 2; return st * 1024 + (ob ^ (((ob >> 9) & 1) << 5)); }
__host__ __device__ __forceinline__ void stage_rc(int b, int& R, int& C) { const int st = b / 1024, sb = b % 1024, swz = sb ^ (((sb >> 9) & 1) << 5); R = (st >> 1) * 16 + swz / 64; C = (st & 1) * 32 + (swz % 64) / 2; }
__host__ __device__ __forceinline__ int perm32(int rho) { const int n = rho >> 4, i = rho & 15; return 8 * (i >> 2) + 4 * n + (i & 3); }

struct Unit { int pm, pn; };
struct Gemm { const bf16_t* A; const bf16_t* Bt; int M, N, K; };

struct StaticOrder {
    int nM, nN, nwg, G, c;
    __host__ __device__ void init(int M, int N, int G_, int c_) { nM = M / BM; nN = N / BM; nwg = nM * nN; G = G_; c = c_; }
    __host__ __device__ bool next(int i, Unit& u) const {
        const long L = (long)i * G + c; if (L >= nwg) return false;
        int wgid = (int)L; { const int q = nwg / NXCD, r = nwg % NXCD, xcd = wgid % NXCD, off = wgid / NXCD; wgid = (xcd < r ? xcd * (q + 1) : r * (q + 1) + (xcd - r) * q) + off; }
        const int nig = WGM * nN, gid = wgid / nig, fm = gid * WGM, gsz = (nM - fm) < WGM ? (nM - fm) : WGM;
        u.pm = fm + ((wgid % nig) % gsz); u.pn = (wgid % nig) / gsz; return true;
    }
    __device__ __forceinline__ void a_ready(const Unit&) const {}
    __device__ __forceinline__ void done(const Unit&) const {}
};

__device__ __forceinline__ unsigned cvt_pk_bf16(float lo, float hi) { unsigned r; asm volatile("v_cvt_pk_bf16_f32 %0, %1, %2" : "=v"(r) : "v"(lo), "v"(hi)); return r; }
typedef float f32x2 __attribute__((ext_vector_type(2)));
__device__ __forceinline__ float sum_xor32(float x) { const unsigned u = __builtin_bit_cast(unsigned, x); auto r = __builtin_amdgcn_permlane32_swap(u, u, false, false); return __builtin_bit_cast(float, (unsigned)r[0]) + __builtin_bit_cast(float, (unsigned)r[1]); }
__device__ __forceinline__ float other_half(float x, bool upper) { const unsigned u = __builtin_bit_cast(unsigned, x); auto r = __builtin_amdgcn_permlane32_swap(u, u, false, false); return __builtin_bit_cast(float, (unsigned)(upper ? r[0] : r[1])); }
__device__ __forceinline__ float other_row16(float x, bool oddrow) { const unsigned u = __builtin_bit_cast(unsigned, x); auto r = __builtin_amdgcn_permlane16_swap(u, u, false, false); return __builtin_bit_cast(float, (unsigned)(oddrow ? r[0] : r[1])); }
__device__ __forceinline__ float rstd_of(const float* ssq, int row) { return rsqrtf(ssq[row] * (1.0f / 1024.0f) + 1e-6f); }
typedef unsigned u32x2 __attribute__((ext_vector_type(2)));
struct EpiScale {
    static constexpr bool PERM = false, AFTER_DRAIN = false;
    bf16_t* O; int ldc; const float* ssq;
    __device__ __forceinline__ void operator()(const f32x4 (&acc)[2][2][4][2], const Unit& u, int wr, int wc, int fr, int fq) const {
        const int row0 = u.pm * BM + wr * 64 + fr, col0 = u.pn * BM + wc * 32 + 4 * fq;
#pragma unroll
        for (int ai = 0; ai < 2; ++ai)
#pragma unroll
            for (int m = 0; m < 4; ++m) { const int row = row0 + ai * HALF + m * 16; const float rs = rstd_of(ssq, row); bf16_t* rp = O + (size_t)row * ldc + col0;
#pragma unroll
                for (int bj = 0; bj < 2; ++bj)
#pragma unroll
                    for (int n = 0; n < 2; ++n) { const f32x4 v = acc[ai][bj][m][n] * rs; u32x2 w; w.x = cvt_pk_bf16(v[0], v[1]); w.y = cvt_pk_bf16(v[2], v[3]); *(u32x2*)(rp + bj * HALF + n * 16) = w; } }
    }
};
struct EpiResid {
    static constexpr bool PERM = true, AFTER_DRAIN = false;
    const float* xin; float* xout; bf16_t* xb; float* ssq_next;
    __device__ __forceinline__ void operator()(const f32x4 (&acc)[2][2][4][2], const Unit& u, int wr, int wc, int fr_in, int fq_in) const {
        int fr = fr_in, fq = fq_in; asm volatile("" : "+v"(fr), "+v"(fq));
        const int row0 = u.pm * BM + wr * 64 + fr, col0 = u.pn * BM + wc * 32 + 8 * fq;
#pragma unroll
        for (int ai = 0; ai < 2; ++ai) {
            f32x4 pre[4][2][2];
#pragma unroll
            for (int m = 0; m < 4; ++m) { const size_t off = (size_t)(row0 + ai * HALF + m * 16) * 1024 + col0;
#pragma unroll
                for (int bj = 0; bj < 2; ++bj)
#pragma unroll
                    for (int n = 0; n < 2; ++n) pre[m][bj][n] = *(const f32x4*)(xin + off + bj * HALF + 4 * n); }
#pragma unroll
            for (int m = 0; m < 4; ++m) { const int row = row0 + ai * HALF + m * 16; const size_t off = (size_t)row * 1024 + col0; float s = 0.f;
#pragma unroll
                for (int bj = 0; bj < 2; ++bj) { const size_t o2 = off + bj * HALF;
                    const f32x4 x0 = pre[m][bj][0] + acc[ai][bj][m][0], x1 = pre[m][bj][1] + acc[ai][bj][m][1];
                    *(f32x4*)(xout + o2) = x0; *(f32x4*)(xout + o2 + 4) = x1;
                    if (xb) { u32x4 w; w.x = cvt_pk_bf16(x0[0], x0[1]); w.y = cvt_pk_bf16(x0[2], x0[3]); w.z = cvt_pk_bf16(x1[0], x1[1]); w.w = cvt_pk_bf16(x1[2], x1[3]); *(u32x4*)(xb + o2) = w;
                        s += ((x0[0] * x0[0] + x0[1] * x0[1]) + (x0[2] * x0[2] + x0[3] * x0[3])) + ((x1[0] * x1[0] + x1[1] * x1[1]) + (x1[2] * x1[2] + x1[3] * x1[3])); } }
                if (xb) { s += __shfl_xor(s, 16); s = sum_xor32(s); if (fq == 0) __hip_atomic_fetch_add(ssq_next + row, s, __ATOMIC_RELAXED, __HIP_MEMORY_SCOPE_AGENT); } }
            asm volatile("" ::: "memory");
        }
    }
};
struct EpiSwiGLU {
    static constexpr bool PERM = true, AFTER_DRAIN = false;
    bf16_t* H; const float* ssq;
    __device__ __forceinline__ void operator()(const f32x4 (&acc)[2][2][4][2], const Unit& u, int wr, int wc, int fr, int fq) const {
        const int row0 = u.pm * BM + wr * 64 + fr, col0 = u.pn * HALF + wc * 32 + 8 * fq;
#pragma unroll
        for (int ai = 0; ai < 2; ++ai)
#pragma unroll
            for (int m = 0; m < 4; ++m) { const int row = row0 + ai * HALF + m * 16; const float rs = rstd_of(ssq, row); bf16_t* rp = H + (size_t)row * 2816 + col0;
                float h[8];
#pragma unroll
                for (int n = 0; n < 2; ++n) { const f32x4 g = acc[ai][0][m][n] * rs, uu = acc[ai][1][m][n] * rs;
#pragma unroll
                    for (int i = 0; i < 4; ++i) h[4 * n + i] = g[i] * uu[i] * __builtin_amdgcn_rcpf(1.0f + __expf(-g[i])); }
                u32x4 w; w.x = cvt_pk_bf16(h[0], h[1]); w.y = cvt_pk_bf16(h[2], h[3]); w.z = cvt_pk_bf16(h[4], h[5]); w.w = cvt_pk_bf16(h[6], h[7]); *(u32x4*)rp = w; }
    }
};

struct EpiQK {
    static constexpr bool PERM = true, AFTER_DRAIN = false;
    bf16_t* O; int ldc; const float* ssq; int q_lo, q_hi, k_hi; const float* qg; const float* kg; const float* rc; const float* rsn; PG8_LAS float* X;
    __device__ __forceinline__ void operator()(const f32x4 (&acc)[2][2][4][2], const Unit& u, int wr, int wc, int fr_in, int fq_in) const {
        int fr = fr_in, fq = fq_in; asm volatile("" : "+v"(fr), "+v"(fq));
        const int row0 = u.pm * BM + wr * 64 + fr, col0 = u.pn * BM + wc * 32 + 8 * fq;
        const bool isq = (u.pn >= q_lo) && (u.pn < q_hi), isk = (u.pn >= q_hi) && (u.pn < k_hi);
        if (!(isq || isk)) {
#pragma unroll
            for (int ai = 0; ai < 2; ++ai)
#pragma unroll
                for (int m = 0; m < 4; ++m) { const int row = row0 + ai * HALF + m * 16; const float rs = rstd_of(ssq, row); bf16_t* rp = O + (size_t)row * ldc + col0;
#pragma unroll
                    for (int bj = 0; bj < 2; ++bj) { const f32x4 v0 = acc[ai][bj][m][0] * rs, v1 = acc[ai][bj][m][1] * rs;
                        u32x4 w; w.x = cvt_pk_bf16(v0[0], v0[1]); w.y = cvt_pk_bf16(v0[2], v0[3]); w.z = cvt_pk_bf16(v1[0], v1[1]); w.w = cvt_pk_bf16(v1[2], v1[3]); *(u32x4*)(rp + bj * HALF) = w; } }
            return;
        }
#pragma unroll
        for (int ai = 0; ai < 2; ++ai)
#pragma unroll
            for (int m = 0; m < 4; ++m) { const int rl = ai * HALF + wr * 64 + m * 16 + fr;
#pragma unroll
                for (int bj = 0; bj < 2; ++bj) { float s = 0.f;
#pragma unroll
                    for (int n = 0; n < 2; ++n) { const f32x4 v = acc[ai][bj][m][n]; s += (v[0] * v[0] + v[1] * v[1]) + (v[2] * v[2] + v[3] * v[3]); }
                    s += __shfl_xor(s, 16); s = sum_xor32(s);
                    if (fq == 0) X[(rl * 2 + bj) * 4 + wc] = s; } }
        asm volatile("s_waitcnt lgkmcnt(0)\n\ts_barrier" ::: "memory");
        const float* g = isq ? qg : kg; const float scale = isq ? (0.125f * 1.4426950408889634f) : 1.0f;
        const f32x4 g0 = *(const f32x4*)(g + 32 * (wc & 1) + 8 * fq), g1 = *(const f32x4*)(g + 32 * (wc & 1) + 8 * fq + 4);
        const bool rot = ((wc & 1) == 0) && (fq < 2);
#pragma unroll
        for (int ai = 0; ai < 2; ++ai)
#pragma unroll
            for (int m = 0; m < 4; ++m) { const int rl = ai * HALF + wr * 64 + m * 16 + fr, row = u.pm * BM + rl; const float rs = rstd_of(ssq, row); bf16_t* rp = O + (size_t)row * ldc + col0;
                const int pos = row & 2047;
                f32x4 c0 = {1.f, 1.f, 1.f, 1.f}, c1 = c0, s0 = {0.f, 0.f, 0.f, 0.f}, s1 = s0;
                if (rot) { c0 = *(const f32x4*)(rc + pos * 8); c1 = *(const f32x4*)(rc + pos * 8 + 4); s0 = *(const f32x4*)(rsn + pos * 8); s1 = *(const f32x4*)(rsn + pos * 8 + 4); if (fq == 0) { s0 = -s0; s1 = -s1; } }
#pragma unroll
                for (int bj = 0; bj < 2; ++bj) { const float hs = (X[(rl * 2 + bj) * 4 + wc] + X[(rl * 2 + bj) * 4 + (wc ^ 1)]) * (rs * rs);
                    const float hr = rsqrtf(hs * (1.0f / 64.0f) + 1e-6f) * rs;
                    f32x4 v0 = acc[ai][bj][m][0] * hr * g0, v1 = acc[ai][bj][m][1] * hr * g1;
                    f32x4 p0, p1;
#pragma unroll
                    for (int i = 0; i < 4; ++i) { p0[i] = other_row16(v0[i], (fq & 1) != 0); p1[i] = other_row16(v1[i], (fq & 1) != 0); }
                    v0 = v0 * c0 + p0 * s0; v1 = v1 * c1 + p1 * s1;
                    v0 = v0 * scale; v1 = v1 * scale;
                    u32x4 w; w.x = cvt_pk_bf16(v0[0], v0[1]); w.y = cvt_pk_bf16(v0[2], v0[3]); w.z = cvt_pk_bf16(v1[0], v1[1]); w.w = cvt_pk_bf16(v1[2], v1[3]);
                    *(u32x4*)(rp + bj * HALF) = w; } }
    }
};

template <class Epi, class Sched, bool ALIGN_EPI = false, bool SP2 = false>
__device__ __forceinline__ void gemm_phase(PG8_LAS unsigned char* lds, const Gemm g, const Sched& S, const Epi& E) {
    const int tid = opaque_tid(), wid = __builtin_amdgcn_readfirstlane(tid >> 6), lane = tid & 63, wr = wid >> 2, wc = wid & 3, fr = lane & 15, fq = lane >> 4;
    const int K = g.K, nt = K / BK;
    unsigned voffA[2], voffB[2];
#pragma unroll
    for (int i = 0; i < 2; ++i) { int R, C; stage_rc(tid * 16 + i * 8192, R, C); const int Rb = Epi::PERM ? ((R & ~31) + perm32(R & 31)) : R;
        voffA[i] = (unsigned)(R * K + C) * 2u; voffB[i] = (unsigned)(Rb * K + C) * 2u; }
    const size_t kstep = (size_t)(BK * 2);
    const size_t hstep = (size_t)HALF * K * 2;
    const size_t tstep = 2 * hstep;
    const unsigned ldsw = (unsigned)wid * 1024u;
    const int aoff = lds_byte(wr * 64 + fr, fq * 8), boff = lds_byte(wc * 32 + fr, fq * 8);
#define PG8_SA(b, h) (((b) * 2 + (h)) * HTB)
#define PG8_SB(b, h) ((4 + (b) * 2 + (h)) * HTB)
#define PG8_STAGE(bufoff, gbase, voff) do { _Pragma("unroll") for (int _i = 0; _i < 2; ++_i) \
        __builtin_amdgcn_global_load_lds((const unsigned*)((const char*)(gbase) + (voff)[_i]), (PG8_LAS unsigned*)(lds + (bufoff) + ldsw + _i * 8192), 16, 0, 0); } while (0)
#define PG8_LDA(dst, b, h) do { _Pragma("unroll") for (int m = 0; m < 4; ++m) _Pragma("unroll") for (int k = 0; k < 2; ++k) dst[m][k] = *(const PG8_LAS bf16x8*)(lds + PG8_SA(b, h) + aoff + m * 2048 + k * 1024); } while (0)
#define PG8_LDB(dst, b, h) do { _Pragma("unroll") for (int n = 0; n < 2; ++n) _Pragma("unroll") for (int k = 0; k < 2; ++k) dst[n][k] = *(const PG8_LAS bf16x8*)(lds + PG8_SB(b, h) + boff + n * 2048 + k * 1024); } while (0)
#define PG8_MMA(ai, bj, At, Bt) do { __builtin_amdgcn_s_setprio(1); _Pragma("unroll") for (int m = 0; m < 4; ++m) _Pragma("unroll") for (int n = 0; n < 2; ++n) _Pragma("unroll") for (int k = 0; k < 2; ++k) \
        acc[ai][bj][m][n] = __builtin_amdgcn_mfma_f32_16x16x32_bf16(Bt[n][k], At[m][k], acc[ai][bj][m][n], 0, 0, 0); __builtin_amdgcn_s_setprio(0); } while (0)
#define PG8_WAIT_V(n) asm volatile("s_waitcnt vmcnt(" #n ")" ::: "memory")
#define PG8_WAIT_L(n) asm volatile("s_waitcnt lgkmcnt(" #n ")" ::: "memory")
#define PG8_BAR __builtin_amdgcn_s_barrier()
#define PG8_SCHED __builtin_amdgcn_sched_barrier(0)
    Unit cur, nxt; int ui = 0;
    if (!S.next(0, cur)) return;
    f32x4 acc[2][2][4][2];
#pragma unroll
    for (int a = 0; a < 2; ++a)
#pragma unroll
        for (int b = 0; b < 2; ++b)
#pragma unroll
            for (int m = 0; m < 4; ++m)
#pragma unroll
                for (int n = 0; n < 2; ++n) acc[a][b][m][n] = (f32x4){0.f, 0.f, 0.f, 0.f};
    bf16x8 At[4][2], B0[2][2], B1[2][2];
    const char* cA = (const char*)g.A + (size_t)cur.pm * tstep; const char* cB = (const char*)g.Bt + (size_t)cur.pn * tstep;
    S.a_ready(cur);
    if constexpr (SP2) {
        PG8_STAGE(PG8_SB(0, 0), cB, voffB); PG8_STAGE(PG8_SB(0, 1), cB + hstep, voffB); PG8_STAGE(PG8_SA(0, 0), cA, voffA); PG8_STAGE(PG8_SA(0, 1), cA + hstep, voffA);
        if (wr == 1) PG8_BAR;
        PG8_WAIT_V(2); PG8_BAR;
        PG8_STAGE(PG8_SB(1, 0), cB + kstep, voffB); PG8_STAGE(PG8_SA(1, 0), cA + kstep, voffA); PG8_STAGE(PG8_SB(1, 1), cB + hstep + kstep, voffB);
        PG8_WAIT_V(6); PG8_BAR;
    } else {
        PG8_STAGE(PG8_SB(0, 0), cB, voffB); PG8_STAGE(PG8_SA(0, 0), cA, voffA); PG8_STAGE(PG8_SB(0, 1), cB + hstep, voffB); PG8_STAGE(PG8_SA(0, 1), cA + hstep, voffA);
        if (wr == 1) PG8_BAR;
        PG8_WAIT_V(4); PG8_BAR;
        PG8_STAGE(PG8_SB(1, 0), cB + kstep, voffB); PG8_STAGE(PG8_SA(1, 0), cA + kstep, voffA); PG8_STAGE(PG8_SB(1, 1), cB + hstep + kstep, voffB);
        PG8_WAIT_V(6); PG8_BAR;
    }
    for (;;) {
        const bool has_next = S.next(ui + 1, nxt);
        const char* nA = has_next ? (const char*)g.A + (size_t)nxt.pm * tstep : cA; const char* nB = has_next ? (const char*)g.Bt + (size_t)nxt.pn * tstep : cB;
        for (int t = 0; t < nt; t += 2) {
            const bool last = (t == nt - 2);
            const char* a1 = cA + (size_t)(t + 1) * kstep;
            const char* a2 = last ? nA : cA + (size_t)(t + 2) * kstep; const char* b2 = last ? nB : cB + (size_t)(t + 2) * kstep;
            const char* a3 = a2 + kstep; const char* b3 = b2 + kstep;
            if (last && has_next) S.a_ready(nxt);
            if constexpr (SP2) {
            PG8_LDB(B0, 0, 0); PG8_LDB(B1, 0, 1); PG8_SCHED; PG8_LDA(At, 0, 0); PG8_STAGE(PG8_SA(1, 1), a1 + hstep, voffA);
            PG8_WAIT_V(8); PG8_WAIT_L(0); PG8_BAR; PG8_MMA(0, 0, At, B0); PG8_MMA(0, 1, At, B1); PG8_BAR; PG8_SCHED;
            PG8_LDA(At, 0, 1); PG8_STAGE(PG8_SB(0, 0), b2, voffB); PG8_STAGE(PG8_SB(0, 1), b2 + hstep, voffB); PG8_STAGE(PG8_SA(0, 0), a2, voffA);
            PG8_WAIT_V(8); PG8_WAIT_L(0); PG8_BAR; PG8_MMA(1, 0, At, B0); PG8_MMA(1, 1, At, B1); PG8_BAR; PG8_SCHED;
            PG8_LDB(B0, 1, 0); PG8_LDB(B1, 1, 1); PG8_SCHED; PG8_LDA(At, 1, 0); PG8_STAGE(PG8_SA(0, 1), a2 + hstep, voffA);
            PG8_WAIT_V(8); PG8_WAIT_L(0); PG8_BAR; PG8_MMA(0, 0, At, B0); PG8_MMA(0, 1, At, B1); PG8_BAR; PG8_SCHED;
            PG8_LDA(At, 1, 1); PG8_STAGE(PG8_SB(1, 0), b3, voffB); PG8_STAGE(PG8_SB(1, 1), b3 + hstep, voffB); PG8_STAGE(PG8_SA(1, 0), a3, voffA);
            PG8_WAIT_V(8); PG8_WAIT_L(0); PG8_BAR; PG8_MMA(1, 0, At, B0); PG8_MMA(1, 1, At, B1); PG8_BAR; PG8_SCHED;
            } else {
            PG8_LDB(B0, 0, 0); PG8_SCHED; PG8_LDA(At, 0, 0); PG8_STAGE(PG8_SA(1, 1), a1 + hstep, voffA);
            PG8_WAIT_L(8); PG8_BAR; PG8_WAIT_L(0); PG8_MMA(0, 0, At, B0); PG8_BAR; PG8_SCHED;
            PG8_LDB(B1, 0, 1); PG8_STAGE(PG8_SB(0, 0), b2, voffB);
            PG8_BAR; PG8_WAIT_L(0); PG8_MMA(0, 1, At, B1); PG8_BAR;
            PG8_LDA(At, 0, 1); PG8_STAGE(PG8_SA(0, 0), a2, voffA);
            PG8_BAR; PG8_WAIT_L(0); PG8_MMA(1, 0, At, B0); PG8_BAR; PG8_SCHED;
            PG8_STAGE(PG8_SB(0, 1), b2 + hstep, voffB);
            PG8_WAIT_V(6); PG8_BAR; PG8_MMA(1, 1, At, B1); PG8_BAR;
            PG8_LDB(B0, 1, 0); PG8_SCHED; PG8_LDA(At, 1, 0); PG8_STAGE(PG8_SA(0, 1), a2 + hstep, voffA);
            PG8_WAIT_L(8); PG8_BAR; PG8_WAIT_L(0); PG8_MMA(0, 0, At, B0); PG8_BAR; PG8_SCHED;
            PG8_LDB(B1, 1, 1); PG8_STAGE(PG8_SB(1, 0), b3, voffB);
            PG8_BAR; PG8_WAIT_L(0); PG8_MMA(0, 1, At, B1); PG8_BAR;
            PG8_LDA(At, 1, 1); PG8_STAGE(PG8_SA(1, 0), a3, voffA);
            PG8_BAR; PG8_WAIT_L(0); PG8_MMA(1, 0, At, B0); PG8_BAR; PG8_SCHED;
            PG8_STAGE(PG8_SB(1, 1), b3 + hstep, voffB);
            PG8_WAIT_V(6); PG8_BAR; PG8_MMA(1, 1, At, B1); PG8_BAR;
            }
        }
        if constexpr (ALIGN_EPI) { if (wr == 0) PG8_BAR; }
        if constexpr (!Epi::AFTER_DRAIN) { E(acc, cur, wr, wc, fr, fq); S.done(cur); }
        if (!has_next) break;
#pragma unroll
        for (int a = 0; a < 2; ++a)
#pragma unroll
            for (int b = 0; b < 2; ++b)
#pragma unroll
                for (int m = 0; m < 4; ++m)
#pragma unroll
                    for (int n = 0; n < 2; ++n) acc[a][b][m][n] = (f32x4){0.f, 0.f, 0.f, 0.f};
        cur = nxt; cA = nA; cB = nB; ++ui;
        if constexpr (ALIGN_EPI) { if (wr == 1) PG8_BAR; }
    }
    PG8_WAIT_V(0);
    if constexpr (!ALIGN_EPI) { if (wr == 0) PG8_BAR; }
    PG8_BAR;
    if constexpr (Epi::AFTER_DRAIN) { E.fused(acc, cur, wr, wc, fr, fq, lds, wid, lane); S.done(cur); }
#undef PG8_SA
#undef PG8_SB
#undef PG8_STAGE
#undef PG8_LDA
#undef PG8_LDB
#undef PG8_MMA
#undef PG8_WAIT_V
#undef PG8_WAIT_L
#undef PG8_BAR
#undef PG8_SCHED
}
}
#define LAS __attribute__((address_space(3)))
typedef unsigned short bf16;
typedef short bf16x8 __attribute__((ext_vector_type(8)));
typedef float f32x4 __attribute__((ext_vector_type(4)));
typedef unsigned u32x4 __attribute__((ext_vector_type(4)));
typedef unsigned u32x2 __attribute__((ext_vector_type(2)));
constexpr int BATCH = 16, SEQ = 2048, DM = 1024, MROWS = BATCH * SEQ, DFF = 2816, NIN = 2560, NQKV = 3072;
constexpr size_t MiB = 1u << 20;
constexpr size_t WS_CTL = 0;
constexpr size_t WS_ROPE = 1 * MiB;
constexpr size_t WS_SSQ = 2 * MiB;
constexpr size_t WS_LSE = 4 * MiB;
constexpr size_t WS_WIN = 16 * MiB, WS_WO0 = 22 * MiB, WS_WGU0 = 24 * MiB, WS_WDN0 = 36 * MiB, WS_WQKV = 42 * MiB, WS_WO1 = 48 * MiB, WS_WGU1 = 50 * MiB, WS_WDN1 = 62 * MiB;
constexpr size_t WS_XB = 68 * MiB;
constexpr size_t WS_A = 132 * MiB;
constexpr size_t WS_B = 324 * MiB;
constexpr size_t WS_C = 388 * MiB;
constexpr size_t WS_END = 452 * MiB;
constexpr int LDS_BYTES = 147456 + 256;
constexpr int LDS_ITEM = 147456;
constexpr int LDS_BARST = 147456 + 64;
constexpr int CW_BAR = 4096;

struct Args { const float* in[27]; float* out; unsigned char* ws; };

__device__ __forceinline__ unsigned cvtpk(float lo, float hi) { typedef float f2 __attribute__((ext_vector_type(2))); typedef __bf16 b2 __attribute__((ext_vector_type(2))); f2 v = {lo, hi}; b2 b = __builtin_convertvector(v, b2); return __builtin_bit_cast(unsigned, b); }
__device__ __forceinline__ float bflo(unsigned u) { return __uint_as_float(u << 16); }
__device__ __forceinline__ float bfhi(unsigned u) { return __uint_as_float(u & 0xffff0000u); }
__device__ __forceinline__ float wave_sum(float v) {
#pragma unroll
    for (int o = 1; o < 64; o <<= 1) v += __shfl_xor(v, o);
    return v;
}
#define LDS_WAIT() asm volatile("s_waitcnt lgkmcnt(0)" ::: "memory")

struct TrItem { const float* W; bf16* WT; const float* gain; int K, N, mode, r; };
__device__ __forceinline__ TrItem tr_decode(const Args& a, int it) {
    constexpr int I_IN = 32 * (NIN / 128), I_O = 32 * 8, I_G = 32 * (DFF / 128), I_D = (DFF / 32) * 8, I_Q = 32 * (NQKV / 128);
    unsigned char* ws = a.ws; int r = it; TrItem d;
    if (r < I_IN) { d = TrItem{a.in[2], (bf16*)(ws + WS_WIN), a.in[1], DM, NIN, 0, r}; return d; } r -= I_IN;
    if (r < I_O) { d = TrItem{a.in[17], (bf16*)(ws + WS_WO0), nullptr, DM, DM, 0, r}; return d; } r -= I_O;
    if (r < I_G) { d = TrItem{a.in[24], (bf16*)(ws + WS_WGU0), a.in[23], DM, DFF, 1, r}; return d; } r -= I_G;
    if (r < I_G) { d = TrItem{a.in[25], (bf16*)(ws + WS_WGU0), a.in[23], DM, DFF, 2, r}; return d; } r -= I_G;
    if (r < I_D) { d = TrItem{a.in[26], (bf16*)(ws + WS_WDN0), nullptr, DFF, DM, 0, r}; return d; } r -= I_D;
    if (r < I_Q) { d = TrItem{a.in[19], (bf16*)(ws + WS_WQKV), a.in[18], DM, NQKV, 0, r}; return d; } r -= I_Q;
    if (r < I_O) { d = TrItem{a.in[22], (bf16*)(ws + WS_WO1), nullptr, DM, DM, 0, r}; return d; } r -= I_O;
    if (r < I_G) { d = TrItem{a.in[24] + (size_t)DM * DFF, (bf16*)(ws + WS_WGU1), a.in[23] + DM, DM, DFF, 1, r}; return d; } r -= I_G;
    if (r < I_G) { d = TrItem{a.in[25] + (size_t)DM * DFF, (bf16*)(ws + WS_WGU1), a.in[23] + DM, DM, DFF, 2, r}; return d; } r -= I_G;
    d = TrItem{a.in[26] + (size_t)DFF * DM, (bf16*)(ws + WS_WDN1), nullptr, DFF, DM, 0, r}; return d;
}
__device__ __forceinline__ void tr_load(const TrItem& d, int lane, f32x4 (&v)[16]) {
    const int nblk = d.N / 128, kb = d.r / nblk, nb = d.r % nblk, k0 = 32 * kb, n0 = 128 * nb;
#pragma unroll
    for (int i = 0; i < 16; ++i) { const int kk = 2 * i + (lane >> 5); v[i] = *(const f32x4*)(d.W + (size_t)(k0 + kk) * d.N + n0 + 4 * (lane & 31)); }
}
__device__ __forceinline__ void tr_store(const TrItem& d, int lane, const f32x4 (&v)[16], LAS float* scr) {
    const int nblk = d.N / 128, kb = d.r / nblk, nb = d.r % nblk, k0 = 32 * kb, n0 = 128 * nb;
#pragma unroll
    for (int i = 0; i < 16; ++i) { const int kk = 2 * i + (lane >> 5); const float gv = d.gain ? d.gain[k0 + kk] : 1.0f; *(LAS f32x4*)(scr + kk * 132 + 4 * (lane & 31)) = v[i] * gv; }
    LDS_WAIT();
    const int rbase = (d.mode == 0) ? n0 : (256 * (n0 >> 7) + (d.mode == 2 ? 128 : 0));
#pragma unroll
    for (int h = 0; h < 2; ++h) { const int n = lane + 64 * h; const LAS float* s = scr + n; u32x4* dst = (u32x4*)(d.WT + (size_t)(rbase + n) * d.K + k0);
#pragma unroll
        for (int q = 0; q < 4; ++q) { u32x4 o; o.x = cvtpk(s[(8 * q + 0) * 132], s[(8 * q + 1) * 132]); o.y = cvtpk(s[(8 * q + 2) * 132], s[(8 * q + 3) * 132]); o.z = cvtpk(s[(8 * q + 4) * 132], s[(8 * q + 5) * 132]); o.w = cvtpk(s[(8 * q + 6) * 132], s[(8 * q + 7) * 132]); dst[q] = o; } }
    LDS_WAIT();
}
__device__ __forceinline__ void p0_prologue(const Args& a, LAS unsigned char* lds) {
    const int tid = opaque_tid(), lane = tid & 63, wave = __builtin_amdgcn_readfirstlane(tid >> 6);
    unsigned char* ws = a.ws;
    LAS float* scr = (LAS float*)(lds + wave * 17408);
    const int gw = blockIdx.x * 8 + wave, NGW = gridDim.x * 8;
    constexpr int NITEMS = 32 * (NIN / 128) + 2 * 32 * 8 + 4 * 32 * (DFF / 128) + 2 * (DFF / 32) * 8 + 32 * (NQKV / 128);
    { f32x4 va[16], vb[16];
      int it = gw; TrItem cur = tr_decode(a, it < NITEMS ? it : 0);
      if (it < NITEMS) tr_load(cur, lane, va);
      while (it < NITEMS) {
          const int i1 = it + NGW; TrItem d1 = cur; if (i1 < NITEMS) { d1 = tr_decode(a, i1); tr_load(d1, lane, vb); }
          tr_store(cur, lane, va, scr);
          if (i1 >= NITEMS) break;
          const int i2 = i1 + NGW; if (i2 < NITEMS) { cur = tr_decode(a, i2); tr_load(cur, lane, va); }
          tr_store(d1, lane, vb, scr);
          it = i2;
      } }
    const float* x = a.in[0]; bf16* xb = (bf16*)(ws + WS_XB); float* ssq = (float*)(ws + WS_SSQ);
    for (int m0 = gw * 4; m0 < MROWS; m0 += NGW * 4) {
        f32x4 v[4][4];
#pragma unroll
        for (int r = 0; r < 4; ++r)
#pragma unroll
            for (int j = 0; j < 4; ++j) v[r][j] = ((const f32x4*)(x + (size_t)(m0 + r) * DM) + lane)[64 * j];
#pragma unroll
        for (int r = 0; r < 4; ++r) { unsigned long long* o8 = (unsigned long long*)(xb + (size_t)(m0 + r) * DM) + lane; float s = 0.f;
#pragma unroll
            for (int j = 0; j < 4; ++j) { const f32x4 q = v[r][j]; s += (q[0] * q[0] + q[1] * q[1]) + (q[2] * q[2] + q[3] * q[3]); o8[64 * j] = (unsigned long long)cvtpk(q[0], q[1]) | ((unsigned long long)cvtpk(q[2], q[3]) << 32); }
            s = wave_sum(s);
            if (lane == 0) ssq[m0 + r] = s; }
    }
    const int gt = blockIdx.x * 512 + tid, NGT = gridDim.x * 512;
    for (int i = gt; i < 3 * MROWS; i += NGT) ssq[MROWS + i] = 0.f;
    for (int i = gt; i < 16384; i += NGT) ((unsigned*)(ws + WS_CTL))[i] = 0u;
    float* rc = (float*)(ws + WS_ROPE); float* rsn = rc + SEQ * 8;
    for (int i = gt; i < SEQ * 8; i += NGT) { const int pos = i >> 3, j = i & 7; const float inv = exp2f(-2.3664460711655217f * (float)j); const float ang = (float)pos * inv; double rev = (double)ang * 0.15915494309189535; rev -= rint(rev); rc[i] = __builtin_amdgcn_cosf((float)rev); rsn[i] = __builtin_amdgcn_sinf((float)rev); }
}
#define XB_TMO      128
#define XB_XCNT(j)  (256  + 64 * (j))
#define XB_XSUB(j)  (1280 + 64 * (j))
#define XB_XGEN(j)  (2304 + 64 * (j))
#define XB_TOP      3328
#define XB_TOPGEN   3392
#define XCD_BAR_WORDS 3456
#define XB_SPIN_CAP (1u << 18)

__device__ __forceinline__ unsigned xb_ld(unsigned* p)              { return __hip_atomic_load(p, __ATOMIC_RELAXED, __HIP_MEMORY_SCOPE_AGENT); }
__device__ __forceinline__ unsigned xb_add(unsigned* p, unsigned v) { return __hip_atomic_fetch_add(p, v, __ATOMIC_RELAXED, __HIP_MEMORY_SCOPE_AGENT); }
__device__ __forceinline__ unsigned xb_xcc_id() { return (unsigned)__builtin_amdgcn_s_getreg((3 << 11) | 20) & 0xFu; }
#define XB_SPIN(cond, bar) do { unsigned _sp = 0; while (cond) { __builtin_amdgcn_s_sleep(1); \
    if ((++_sp & 255u) == 0u) { if (xb_ld(&(bar)[XB_TMO])) break; if (_sp > XB_SPIN_CAP) { atomicAdd(&(bar)[XB_TMO], 1u); break; } } } } while (0)

struct XcdBarrier {
    unsigned* bar; unsigned x;
    volatile LAS unsigned* st;
};

__device__ __forceinline__ XcdBarrier xcd_barrier_post(unsigned* bar, volatile LAS unsigned* st) {
    XcdBarrier b; b.bar = bar; b.x = xb_xcc_id(); b.st = st;
    if (threadIdx.x == 0) (void)xb_add(&bar[XB_XCNT(b.x)], 1u);
    return b;
}
__device__ __forceinline__ void xcd_barrier_complete(unsigned* bar, unsigned x, unsigned& nloc, unsigned& nx) {
    const unsigned G = gridDim.x * gridDim.y * gridDim.z;
    unsigned sum, cnt, mine, sp = 0u;
    for (;;) {
        sum = 0u; cnt = 0u; mine = 0u;
#pragma unroll
        for (unsigned j = 0; j < 16; ++j) { const unsigned c = xb_ld(&bar[XB_XCNT(j)]); sum += c; cnt += (c > 0u) ? 1u : 0u; mine = (j == x) ? c : mine; }
        if (sum == G) break;
        __builtin_amdgcn_s_sleep(1);
        if ((++sp & 255u) == 0u) { if (xb_ld(&bar[XB_TMO])) break; if (sp > XB_SPIN_CAP) { atomicAdd(&bar[XB_TMO], 1u); break; } }
    }
    nloc = mine > 0u ? mine : 1u; nx = cnt > 0u ? cnt : 1u;
}

__device__ __forceinline__ void xcd_barrier(const XcdBarrier& b) {
    asm volatile("s_waitcnt vmcnt(0)" ::: "memory");
    __syncthreads();
    if (threadIdx.x == 0) {
        unsigned* bar = b.bar;
        __builtin_amdgcn_s_waitcnt(0);
        unsigned nloc = b.st[0], nx = b.st[1];
        if (nloc == 0u) { xcd_barrier_complete(bar, b.x, nloc, nx); b.st[0] = nloc; b.st[1] = nx; }
        const unsigned old = xb_add(&bar[XB_XSUB(b.x)], 1u);
        const unsigned gen = old / nloc;
        if (old + 1u == (gen + 1u) * nloc) {
            __builtin_amdgcn_fence(__ATOMIC_RELEASE, "agent");
            asm volatile("s_waitcnt vmcnt(0)" ::: "memory");
            const unsigned og = xb_add(&bar[XB_TOP], 1u);
            const unsigned tg = og / nx;
            if (og + 1u == (tg + 1u) * nx) xb_add(&bar[XB_TOPGEN], 1u);
            else XB_SPIN(xb_ld(&bar[XB_TOPGEN]) == tg, bar);
            __builtin_amdgcn_fence(__ATOMIC_ACQUIRE, "agent");
            xb_add(&bar[XB_XGEN(b.x)], 1u);
            asm volatile("s_waitcnt vmcnt(0)" ::: "memory");
        } else {
            XB_SPIN(xb_ld(&bar[XB_XGEN(b.x)]) == gen, bar);
            __builtin_amdgcn_fence(__ATOMIC_ACQUIRE, "agent");
            asm volatile("s_waitcnt vmcnt(0)" ::: "memory");
        }
    }
    __syncthreads();
}

__device__ __forceinline__ void rglru_unit(LAS unsigned char* lds, const Args& a, int b, int g) {
    const int tid = opaque_tid(), lane = tid & 63, w = __builtin_amdgcn_readfirstlane(tid >> 6), lg = lane >> 4, li = lane & 15;
    LAS bf16* Ub = (LAS bf16*)(lds);
    LAS bf16* Wat = (LAS bf16*)(lds + 18432);
    LAS bf16* Wxt = (LAS bf16*)(lds + 27648);
    constexpr int FP = 68;
    LAS float* Uf = (LAS float*)(lds + 36864);
    LAS float* Af = (LAS float*)(lds + 36864 + 34816);
    LAS float* Bf = (LAS float*)(lds + 36864 + 2 * 34816);
    LAS float* Pap = (LAS float*)(lds + 141312);
    LAS float* Phl = (LAS float*)(lds + 143360);
    LAS float* Car = (LAS float*)(lds + 145408);
    const bf16* proj = (const bf16*)(a.ws + WS_A) + (size_t)b * SEQ * NIN;
    bf16* ycat = (bf16*)(a.ws + WS_B) + (size_t)b * SEQ * DM;
    const float* wa = a.in[5] + (size_t)g * 4096; const float* wx = a.in[7] + (size_t)g * 4096;
#pragma unroll
    for (int e = 0; e < 8; ++e) { const int idx = tid + 512 * e, i = idx >> 6, j = idx & 63; Wat[j * 72 + i] = (bf16)(cvtpk(wa[idx], 0.f) & 0xffffu); Wxt[j * 72 + i] = (bf16)(cvtpk(wx[idx], 0.f) & 0xffffu); }
    if (tid < 64) Car[tid] = 0.f;
    const int c2 = tid & 31, tg = tid >> 5, ch0 = 64 * g + 2 * c2;
    float cw[4][2], cb[2];
#pragma unroll
    for (int j = 0; j < 4; ++j) { cw[j][0] = a.in[3][j * 512 + ch0]; cw[j][1] = a.in[3][j * 512 + ch0 + 1]; }
    cb[0] = a.in[4][ch0]; cb[1] = a.in[4][ch0 + 1];
    float cba[4], cbx[4], csp[4];
#pragma unroll
    for (int nt = 0; nt < 4; ++nt) { const int ch = 64 * g + 16 * nt + li; cba[nt] = a.in[6][ch]; cbx[nt] = a.in[8][ch]; const float lam = a.in[9][ch]; csp[nt] = log1pf(__expf(-lam)); }
    const int sc = lane, ss = w;
    unsigned xwr[11];
#pragma unroll
    for (int i = 0; i < 11; ++i) { const int tok = tg * 8 + i - 3; xwr[i] = tok >= 0 ? *(const unsigned*)(proj + (size_t)tok * NIN + ch0) : 0u; }
    for (int ck = 0; ck < SEQ / 128; ++ck) {
        const int s0 = ck * 128;
        BAR_LDS();
        { float xw[11][2];
#pragma unroll
          for (int i = 0; i < 11; ++i) { xw[i][0] = bflo(xwr[i]); xw[i][1] = bfhi(xwr[i]); }
          if (ck + 1 < SEQ / 128) {
#pragma unroll
              for (int i = 0; i < 11; ++i) xwr[i] = *(const unsigned*)(proj + (size_t)(s0 + 128 + tg * 8 + i - 3) * NIN + ch0); }
#pragma unroll
          for (int i = 0; i < 8; ++i) { float u0 = cb[0], u1 = cb[1];
#pragma unroll
              for (int j = 0; j < 4; ++j) { u0 += cw[j][0] * xw[i + j][0]; u1 += cw[j][1] * xw[i + j][1]; }
              const int t = tg * 8 + i; Uf[t * FP + 2 * c2] = u0; Uf[t * FP + 2 * c2 + 1] = u1; *(LAS unsigned*)(Ub + t * 72 + 2 * c2) = cvtpk(u0, u1); } }
        BAR_LDS();
        f32x4 accR[4], accI[4];
#pragma unroll
        for (int nt = 0; nt < 4; ++nt) { accR[nt] = (f32x4){0.f, 0.f, 0.f, 0.f}; accI[nt] = (f32x4){0.f, 0.f, 0.f, 0.f}; }
#pragma unroll
        for (int ks = 0; ks < 2; ++ks) { const bf16x8 af = *(const LAS bf16x8*)(Ub + (16 * w + li) * 72 + 32 * ks + 8 * lg);
#pragma unroll
            for (int nt = 0; nt < 4; ++nt) { const bf16x8 b1 = *(const LAS bf16x8*)(Wat + (16 * nt + li) * 72 + 32 * ks + 8 * lg), b2 = *(const LAS bf16x8*)(Wxt + (16 * nt + li) * 72 + 32 * ks + 8 * lg);
                accR[nt] = __builtin_amdgcn_mfma_f32_16x16x32_bf16(af, b1, accR[nt], 0, 0, 0); accI[nt] = __builtin_amdgcn_mfma_f32_16x16x32_bf16(af, b2, accI[nt], 0, 0, 0); } }
#pragma unroll
        for (int nt = 0; nt < 4; ++nt)
#pragma unroll
            for (int i = 0; i < 4; ++i) { const int t = 16 * w + 4 * lg + i, c = 16 * nt + li;
                const float r = __builtin_amdgcn_rcpf(1.0f + __expf(-(accR[nt][i] + cba[nt]))), ig = __builtin_amdgcn_rcpf(1.0f + __expf(-(accI[nt][i] + cbx[nt])));
                const float la = -8.0f * r * csp[nt]; const float av = __expf(la); const float bv = __builtin_amdgcn_sqrtf(fmaxf(fmaf(-av, av, 1.0f), 0.f)) * (ig * Uf[t * FP + c]);
                Af[t * FP + c] = av; Bf[t * FP + c] = bv; }
        unsigned short gv[16];
#pragma unroll
        for (int i = 0; i < 16; ++i) gv[i] = proj[(size_t)(s0 + 16 * ss + i) * NIN + 512 + 64 * g + sc];
        BAR_LDS();
        float hl[16], ap[16]; { float h = 0.f, p = 1.f;
#pragma unroll
          for (int i = 0; i < 16; ++i) { const float av = Af[(16 * ss + i) * FP + sc], bv = Bf[(16 * ss + i) * FP + sc]; h = av * h + bv; p *= av; hl[i] = h; ap[i] = p; }
          Pap[ss * 64 + sc] = p; Phl[ss * 64 + sc] = h; }
        BAR_LDS();
        float hin = Car[(ck & 1) * 64 + sc];
        for (int j = 0; j < ss; ++j) hin = Pap[j * 64 + sc] * hin + Phl[j * 64 + sc];
#pragma unroll
        for (int i = 0; i < 16; ++i) { const float h = hl[i] + ap[i] * hin; const float x = bflo(gv[i]); const float z = 0.7978845608028654f * (x + 0.044715f * x * x * x);
            const float ge = x * __builtin_amdgcn_rcpf(1.0f + __expf(-2.0f * z)); ycat[(size_t)(s0 + 16 * ss + i) * DM + 64 * g + sc] = (bf16)(cvtpk(h * ge, 0.f) & 0xffffu);
            if (i == 15 && ss == 7) Car[((ck + 1) & 1) * 64 + sc] = h; }
    }
    BAR_LDS();
}
typedef short v4i16_t __attribute__((ext_vector_type(4)));
__device__ __forceinline__ u32x2 tr_read4(const LAS bf16* p) { return __builtin_bit_cast(u32x2, __builtin_amdgcn_ds_read_tr16_b64_v4i16((LAS v4i16_t*)p)); }
__device__ __forceinline__ float score_bound(const float* qg, const float* kg, int lane) {
    float a = fabsf(qg[lane]), b = fabsf(kg[lane]);
#pragma unroll
    for (int o = 1; o < 64; o <<= 1) { a = fmaxf(a, __shfl_xor(a, o)); b = fmaxf(b, __shfl_xor(b, o)); }
    return 8.0f * 1.4426950408889634f * a * b * 1.01f + 0.5f;
}
struct AttnArgs {
    const bf16* Q; const bf16* K; const bf16* V; int ld;
    int qc0, T1;
    bf16* O; int ldo; float lam; const float* subg; float mb;
};
__device__ __forceinline__ void diff_unit(LAS unsigned char* lds, const AttnArgs A) {
    constexpr int NC = 2, DV = 128, QP = NC * 64 + 8, VP = DV + 16, NDT = DV / 16, NVH = DV / 64;
    const int tid = opaque_tid(), lane = tid & 63, w = __builtin_amdgcn_readfirstlane(tid >> 6), lg = lane >> 4, li = lane & 15;
    constexpr int TBUF = 64 * QP + 64 * VP;
    const int krow = tid >> 3, c8 = tid & 7;
    u32x4 kraw[NC], vraw[NVH];
#define ATT_LOAD(T) do { const int tk_ = 64 * (T) + krow; \
        _Pragma("unroll") for (int c = 0; c < NC; ++c) kraw[c] = *(const u32x4*)(A.K + (size_t)tk_ * A.ld + c * 64 + 8 * c8); \
        _Pragma("unroll") for (int hh = 0; hh < NVH; ++hh) vraw[hh] = *(const u32x4*)(A.V + (size_t)tk_ * A.ld + hh * 64 + 8 * c8); } while (0)
#define ATT_WRITE(buf) do { LAS bf16* Ks_ = (LAS bf16*)lds + (buf) * TBUF; LAS bf16* Vs_ = Ks_ + 64 * QP; \
        _Pragma("unroll") for (int c = 0; c < NC; ++c) *(LAS u32x4*)(Ks_ + krow * QP + c * 64 + 8 * c8) = kraw[c]; \
        _Pragma("unroll") for (int hh = 0; hh < NVH; ++hh) *(LAS u32x4*)(Vs_ + krow * VP + hh * 64 + 8 * c8) = vraw[hh]; } while (0)
    ATT_LOAD(0);
    const int qw = A.qc0 + 16 * w, qc = qw + li;
    bf16x8 qf[NC][2];
#pragma unroll
    for (int c = 0; c < NC; ++c)
#pragma unroll
        for (int ks = 0; ks < 2; ++ks) qf[c][ks] = *(const bf16x8*)(A.Q + (size_t)qc * A.ld + c * 64 + 32 * ks + 8 * lg);
    float lrun[NC]; f32x4 O[NC][NDT];
#pragma unroll
    for (int c = 0; c < NC; ++c) { lrun[c] = 0.f;
#pragma unroll
        for (int dt = 0; dt < NDT; ++dt) O[c][dt] = (f32x4){0.f, 0.f, 0.f, 0.f}; }
    const float nmb = -A.mb;
    BAR_LDS();
    ATT_WRITE(0);
    if (1 < A.T1) ATT_LOAD(1);
    BAR_LDS();
    for (int T = 0; T < A.T1; ++T) {
        const LAS bf16* Ks = (const LAS bf16*)lds + (T & 1) * TBUF; const LAS bf16* Vs = Ks + 64 * QP;
        const int k0 = 64 * T;
        if (k0 <= qw + 15) {
            const bool domask = (k0 + 63 > qw);
            bf16x8 pf[NC][2];
#pragma unroll
            for (int c = 0; c < NC; ++c) {
                f32x4 s[4];
#pragma unroll
                for (int nt = 0; nt < 4; ++nt) { s[nt] = (f32x4){nmb, nmb, nmb, nmb};
#pragma unroll
                    for (int ks = 0; ks < 2; ++ks) { const bf16x8 kf = *(const LAS bf16x8*)(Ks + (16 * nt + li) * QP + c * 64 + 32 * ks + 8 * lg); s[nt] = __builtin_amdgcn_mfma_f32_16x16x32_bf16(kf, qf[c][ks], s[nt], 0, 0, 0); } }
                if (domask) {
#pragma unroll
                    for (int nt = 0; nt < 4; ++nt)
#pragma unroll
                        for (int i = 0; i < 4; ++i) { const int kc = k0 + 16 * nt + 4 * lg + i; if (kc > qc) s[nt][i] = -1e30f; }
                }
                float lsum = 0.f;
#pragma unroll
                for (int nt = 0; nt < 4; ++nt)
#pragma unroll
                    for (int i = 0; i < 4; ++i) { const float p = __builtin_amdgcn_exp2f(s[nt][i]); s[nt][i] = p; lsum += p; }
                lrun[c] += lsum;
#pragma unroll
                for (int kp = 0; kp < 2; ++kp) { u32x4 pk; pk.x = cvtpk(s[2 * kp][0], s[2 * kp][1]); pk.y = cvtpk(s[2 * kp][2], s[2 * kp][3]); pk.z = cvtpk(s[2 * kp + 1][0], s[2 * kp + 1][1]); pk.w = cvtpk(s[2 * kp + 1][2], s[2 * kp + 1][3]); pf[c][kp] = __builtin_bit_cast(bf16x8, pk); }
            }
#pragma unroll
            for (int dt = 0; dt < NDT; ++dt)
#pragma unroll
                for (int kp = 0; kp < 2; ++kp) { const u32x2 lo = tr_read4(Vs + (32 * kp + 4 * lg + (li >> 2)) * VP + 16 * dt + 4 * (li & 3)), hi = tr_read4(Vs + (32 * kp + 16 + 4 * lg + (li >> 2)) * VP + 16 * dt + 4 * (li & 3));
                    u32x4 vv; vv.x = lo.x; vv.y = lo.y; vv.z = hi.x; vv.w = hi.y; const bf16x8 vf = __builtin_bit_cast(bf16x8, vv);
#pragma unroll
                    for (int c = 0; c < NC; ++c) O[c][dt] = __builtin_amdgcn_mfma_f32_16x16x32_bf16(vf, pf[c][kp], O[c][dt], 0, 0, 0); }
        }
        if (T + 1 < A.T1) { ATT_WRITE((T + 1) & 1); if (T + 2 < A.T1) ATT_LOAD(T + 2); }
        BAR_LDS();
    }
#undef ATT_LOAD
#undef ATT_WRITE
    float lt[NC];
#pragma unroll
    for (int c = 0; c < NC; ++c) { float l = lrun[c]; l += __shfl_xor(l, 16); l += __shfl_xor(l, 32); lt[c] = l; }
    const float i0 = 1.0f / lt[0], i1 = A.lam / lt[1]; float ssq = 0.f;
#pragma unroll
    for (int dt = 0; dt < NDT; ++dt) { O[0][dt] = O[0][dt] * i0 - O[1][dt] * i1; ssq += (O[0][dt][0] * O[0][dt][0] + O[0][dt][1] * O[0][dt][1]) + (O[0][dt][2] * O[0][dt][2] + O[0][dt][3] * O[0][dt][3]); }
    ssq += __shfl_xor(ssq, 16); ssq += __shfl_xor(ssq, 32);
    const float rs = rsqrtf(ssq * (1.0f / (float)DV) + 1e-6f) * 0.8f;
#pragma unroll
    for (int dt = 0; dt < NDT; ++dt) { const f32x4 gg = *(const f32x4*)(A.subg + 16 * dt + 4 * lg); const f32x4 o = O[0][dt] * gg * rs; u32x2 wv; wv.x = cvtpk(o[0], o[1]); wv.y = cvtpk(o[2], o[3]); *(u32x2*)(A.O + (size_t)qc * A.ldo + 16 * dt + 4 * lg) = wv; }
}

struct DilUnit { const bf16* Q; const bf16* K; const bf16* V; bf16* O; float* lse; int dil, r, n, kbeg, nk; };
__device__ __forceinline__ bf16* op_buf(unsigned char* ws, int p) { return (bf16*)(ws + (p == 0 ? WS_B : (p == 1 ? WS_XB : WS_C))); }
__device__ __forceinline__ DilUnit dil_decode(const Args& a, int i, int G) {
    const int it = blockIdx.x + i * G; const int u = it % 48, bh = it / 48;
    const int b = bh >> 4, h = bh & 15;
    int p, dil, r, n;
    if (u < 16) { p = 0; dil = 1; r = 0; n = u; } else if (u < 32) { p = 1; dil = 4; r = (u - 16) >> 2; n = (u - 16) & 3; } else { p = 2; dil = 16; r = u - 32; n = 0; }
    const bf16* qkv = (const bf16*)(a.ws + WS_A) + (size_t)b * SEQ * NQKV + 64 * h;
    DilUnit U; U.Q = qkv; U.K = qkv + 1024; U.V = qkv + 2048; U.O = op_buf(a.ws, p) + (size_t)b * SEQ * DM + 64 * h;
    U.lse = (float*)(a.ws + WS_LSE) + (size_t)p * MROWS * 16 + (size_t)b * SEQ * 16 + h; U.dil = dil; U.r = r; U.n = n; U.kbeg = n > 0 ? 128 * (n - 1) : 0; U.nk = n > 0 ? 256 : 128;
    return U;
}
template <bool PREV>
__device__ __forceinline__ void dil_compute(const LAS bf16* Ks, const LAS bf16* Vs, bf16x8 qf0, bf16x8 qf1, int w, int lg, int li, float mb, f32x4 (&O)[4], float& lsum_out) {
    constexpr int KP = 72, NS = PREV ? 9 : 8, NPAIR = PREV ? 5 : 4;
    const int st0 = PREV ? w : 0;
    f32x4 s[10];
    {
        bf16x8 kA[NS], kB[NS];
#pragma unroll
        for (int j = 0; j < NS; ++j) { const int st = st0 + j; kA[j] = *(const LAS bf16x8*)(Ks + (16 * st + li) * KP + 8 * lg); kB[j] = *(const LAS bf16x8*)(Ks + (16 * st + li) * KP + 32 + 8 * lg); }
        __builtin_amdgcn_sched_barrier(0);
        const f32x4 zc = {-mb, -mb, -mb, -mb};
#pragma unroll
        for (int j = 0; j < NS; ++j) s[j] = __builtin_amdgcn_mfma_f32_16x16x32_bf16(kA[j], qf0, zc, 0, 0, 0);
#pragma unroll
        for (int j = 0; j < NS; ++j) s[j] = __builtin_amdgcn_mfma_f32_16x16x32_bf16(kB[j], qf1, s[j], 0, 0, 0);
    }
    u32x2 vlo[NPAIR][4], vhi[NPAIR][4];
#pragma unroll
    for (int kp = 0; kp < NPAIR; ++kp) { const int sa = st0 + 2 * kp; int sb = sa + 1; if (PREV && sb > 15) sb = 15;
#pragma unroll
        for (int dt = 0; dt < 4; ++dt) { vlo[kp][dt] = tr_read4(Vs + (16 * sa + 4 * lg + (li >> 2)) * KP + 16 * dt + 4 * (li & 3)); vhi[kp][dt] = tr_read4(Vs + (16 * sb + 4 * lg + (li >> 2)) * KP + 16 * dt + 4 * (li & 3)); } }
    __builtin_amdgcn_sched_barrier(0);
    if (PREV) {
#pragma unroll
        for (int e = 0; e < 4; ++e) { if (li > 4 * lg + e) s[0][e] = -1e30f; if (4 * lg + e > li) s[8][e] = -1e30f; }
    } else {
        const int qrel = 16 * w + li;
#pragma unroll
        for (int j = 0; j < NS; ++j)
#pragma unroll
            for (int e = 0; e < 4; ++e) if (16 * j + 4 * lg + e > qrel) s[j][e] = -1e30f;
    }
    float lsum = 0.f;
#pragma unroll
    for (int j = 0; j < NS; ++j)
#pragma unroll
        for (int e = 0; e < 4; ++e) { const float p = __builtin_amdgcn_exp2f(s[j][e]); s[j][e] = p; lsum += p; }
#pragma unroll
    for (int j = NS; j < 10; ++j) s[j] = (f32x4){0.f, 0.f, 0.f, 0.f};
#pragma unroll
    for (int dt = 0; dt < 4; ++dt) O[dt] = (f32x4){0.f, 0.f, 0.f, 0.f};
#pragma unroll
    for (int kp = 0; kp < NPAIR; ++kp) {
        u32x4 pk; pk.x = cvtpk(s[2 * kp][0], s[2 * kp][1]); pk.y = cvtpk(s[2 * kp][2], s[2 * kp][3]); pk.z = cvtpk(s[2 * kp + 1][0], s[2 * kp + 1][1]); pk.w = cvtpk(s[2 * kp + 1][2], s[2 * kp + 1][3]);
        const bf16x8 pf = __builtin_bit_cast(bf16x8, pk);
#pragma unroll
        for (int dt = 0; dt < 4; ++dt) { u32x4 vv; vv.x = vlo[kp][dt].x; vv.y = vlo[kp][dt].y; vv.z = vhi[kp][dt].x; vv.w = vhi[kp][dt].y; O[dt] = __builtin_amdgcn_mfma_f32_16x16x32_bf16(__builtin_bit_cast(bf16x8, vv), pf, O[dt], 0, 0, 0); }
    }
    lsum += __shfl_xor(lsum, 16); lsum = pg8::sum_xor32(lsum);
    lsum_out = lsum;
}
__device__ __forceinline__ void dil_store(const f32x4 (&O)[4], float lsum, float mb, int lg, bf16* Orow, float* lsep) {
    const float inv = 1.0f / lsum;
    u32x2 wv[4];
#pragma unroll
    for (int dt = 0; dt < 4; ++dt) { const f32x4 o = O[dt] * inv; wv[dt].x = cvtpk(o[0], o[1]); wv[dt].y = cvtpk(o[2], o[3]); }
#pragma unroll
    for (int pr = 0; pr < 2; ++pr) {
        auto rx = __builtin_amdgcn_permlane16_swap(wv[2 * pr].x, wv[2 * pr + 1].x, false, false);
        auto ry = __builtin_amdgcn_permlane16_swap(wv[2 * pr].y, wv[2 * pr + 1].y, false, false);
        u32x4 w; w.x = rx[0]; w.y = ry[0]; w.z = rx[1]; w.w = ry[1];
        *(u32x4*)(Orow + 16 * (2 * pr + (lg & 1)) + 8 * (lg >> 1)) = w; }
    if (lg == 0) *lsep = (mb + __log2f(lsum)) * 0.6931471805599453f;
}
__device__ __forceinline__ void p7_dilated(const Args& a, LAS unsigned char* lds) {
    constexpr int KP = 72, KBYTES = 256 * KP * 2, BUF = 2 * KBYTES, NTOT = BATCH * 16 * 48;
    const int tid = opaque_tid(), lane = tid & 63, w = __builtin_amdgcn_readfirstlane(tid >> 6), lg = lane >> 4, li = lane & 15, krow = tid >> 3, c8 = tid & 7;
    const int G = gridDim.x;
    const float mb = score_bound(a.in[20], a.in[21], lane);
    const int nun = (NTOT - (int)blockIdx.x + G - 1) / G;
    u32x4 kr[4], vr[4]; bf16x8 qn[2];
    DilUnit U = dil_decode(a, 0, G);
#define DIL_LOAD() do { \
        _Pragma("unroll") for (int j = 0; j < 4; ++j) if (64 * j < U.nk) { \
            kr[j] = *(const u32x4*)(U.K + (size_t)((U.kbeg + krow + 64 * j) * U.dil + U.r) * NQKV + 8 * c8); \
            vr[j] = *(const u32x4*)(U.V + (size_t)((U.kbeg + krow + 64 * j) * U.dil + U.r) * NQKV + 8 * c8); } \
        _Pragma("unroll") for (int ks = 0; ks < 2; ++ks) qn[ks] = *(const bf16x8*)(U.Q + (size_t)((128 * U.n + 16 * w + li) * U.dil + U.r) * NQKV + 32 * ks + 8 * lg); } while (0)
#define DIL_WRITE(buf) do { LAS bf16* Ks_ = (LAS bf16*)(lds + (buf) * BUF); LAS bf16* Vs_ = (LAS bf16*)(lds + (buf) * BUF + KBYTES); \
        _Pragma("unroll") for (int j = 0; j < 4; ++j) if (64 * j < U.nk) { \
            *(LAS u32x4*)(Ks_ + (krow + 64 * j) * KP + 8 * c8) = kr[j]; *(LAS u32x4*)(Vs_ + (krow + 64 * j) * KP + 8 * c8) = vr[j]; } } while (0)
    BAR_LDS();
    if (nun > 0) { DIL_LOAD(); DIL_WRITE(0); }
    BAR_LDS();
    DilUnit C = U; bf16x8 qf0 = qn[0], qf1 = qn[1];
    for (int i = 0; i < nun; ++i) {
        const bool more = i + 1 < nun;
        if (more) { U = dil_decode(a, i + 1, G); DIL_LOAD(); }
        const LAS bf16* Ks = (const LAS bf16*)(lds + (i & 1) * BUF); const LAS bf16* Vs = (const LAS bf16*)(lds + (i & 1) * BUF + KBYTES);
        f32x4 O[4]; float lsum;
        if (C.n > 0) dil_compute<true>(Ks, Vs, qf0, qf1, w, lg, li, mb, O, lsum);
        else dil_compute<false>(Ks, Vs, qf0, qf1, w, lg, li, mb, O, lsum);
        const int tokq = (128 * C.n + 16 * w + li) * C.dil + C.r; bf16* Orow = C.O + (size_t)tokq * DM; float* lsep = C.lse + (size_t)tokq * 16;
        if (more) { DIL_WRITE((i + 1) & 1); qf0 = qn[0]; qf1 = qn[1]; C = U; }
        asm volatile("" :: "v"(qf0), "v"(qf1));
        dil_store(O, lsum, mb, lg, Orow, lsep);
        BAR_LDS();
    }
#undef DIL_LOAD
#undef DIL_WRITE
}
__device__ __forceinline__ int next_item(LAS unsigned char* lds, unsigned* ctr) {
    LAS int* slot = (LAS int*)(lds + LDS_ITEM);
    __syncthreads();
    if (threadIdx.x == 0) *slot = (int)__hip_atomic_fetch_add(ctr, 1u, __ATOMIC_RELAXED, __HIP_MEMORY_SCOPE_AGENT);
    __syncthreads();
    return *slot;
}
__device__ __forceinline__ void p2_mixers(const Args& a, LAS unsigned char* lds, int coff) {
    const int lane = opaque_tid() & 63;
    float lam; { const float d1 = wave_sum(a.in[12][lane] * a.in[13][lane]), d2 = wave_sum(a.in[14][lane] * a.in[15][lane]); lam = __expf(d1) - __expf(d2) + 0.2f; }
    unsigned* ctr = (unsigned*)(a.ws + WS_CTL) + coff;
    const float mb = score_bound(a.in[10], a.in[11], lane);
    constexpr int NATT = BATCH * 4 * 16;
#ifndef NO_RGLRU
    for (;;) {
        const int it = next_item(lds, ctr);
        if (it >= 128) break;
        rglru_unit(lds, a, it >> 3, it & 7);
    }
#if PROBE == 20
    for (;;) {
        const int it = next_item(lds, ctr + 16);
        if (it >= 128) break;
        rglru_unit(lds, a, it >> 3, it & 7);
    }
#endif
#endif
#ifndef NO_DIFF
    {
        LAS int* slot = (LAS int*)(lds + LDS_ITEM);
        int j = next_item(lds, ctr + 2);
        while (j < NATT) {
            unsigned nxt = 0u; if (threadIdx.x == 0) nxt = __hip_atomic_fetch_add(ctr + 2, 1u, __ATOMIC_RELAXED, __HIP_MEMORY_SCOPE_AGENT);
            const int qb = 15 - (j >> 6), bh = j & 63, b = bh >> 2, h = bh & 3;
            const bf16* proj = (const bf16*)(a.ws + WS_A) + (size_t)b * SEQ * NIN;
            AttnArgs A; A.Q = proj + 1024 + 128 * h; A.K = proj + 1536 + 128 * h; A.V = proj + 2048 + 128 * h; A.ld = NIN;
            A.qc0 = 128 * qb; A.T1 = 2 * qb + 2;
            A.O = (bf16*)(a.ws + WS_B) + (size_t)b * SEQ * DM + 512 + 128 * h; A.ldo = DM; A.lam = lam; A.subg = a.in[16]; A.mb = mb;
            diff_unit(lds, A);
            if (threadIdx.x == 0) *slot = (int)nxt;
            BAR_LDS();
            j = *slot;
        }
    }
#endif
}
__device__ __forceinline__ void p7b_merge(const Args& a) {
    const int gt = blockIdx.x * 512 + opaque_tid(), NGT = gridDim.x * 512;
    const float* lse = (const float*)(a.ws + WS_LSE);
    bf16* o0 = op_buf(a.ws, 0); const bf16* o1 = op_buf(a.ws, 1); const bf16* o2 = op_buf(a.ws, 2);
    for (int i0 = gt; i0 < MROWS * 128; i0 += 4 * NGT) {
        float l0[4], l1[4], l2[4]; u32x4 v0[4], v1[4], v2[4];
#pragma unroll
        for (int k = 0; k < 4; ++k) { const int i = i0 + k * NGT; const int row = i >> 7, hc = i & 127, h = hc >> 3; const size_t off = (size_t)row * DM + 8 * hc;
            l0[k] = lse[(size_t)row * 16 + h]; l1[k] = lse[(size_t)MROWS * 16 + (size_t)row * 16 + h]; l2[k] = lse[(size_t)2 * MROWS * 16 + (size_t)row * 16 + h];
            v0[k] = *(const u32x4*)(o0 + off); v1[k] = *(const u32x4*)(o1 + off); v2[k] = *(const u32x4*)(o2 + off); }
#pragma unroll
        for (int k = 0; k < 4; ++k) { const int i = i0 + k * NGT; const int row = i >> 7, hc = i & 127; const size_t off = (size_t)row * DM + 8 * hc;
            const float mx = fmaxf(l0[k], fmaxf(l1[k], l2[k])); float e0 = __expf(l0[k] - mx), e1 = __expf(l1[k] - mx), e2 = __expf(l2[k] - mx); const float inv = 1.0f / (e0 + e1 + e2); e0 *= inv; e1 *= inv; e2 *= inv;
            u32x4 o;
            o.x = cvtpk(e0 * bflo(v0[k].x) + e1 * bflo(v1[k].x) + e2 * bflo(v2[k].x), e0 * bfhi(v0[k].x) + e1 * bfhi(v1[k].x) + e2 * bfhi(v2[k].x));
            o.y = cvtpk(e0 * bflo(v0[k].y) + e1 * bflo(v1[k].y) + e2 * bflo(v2[k].y), e0 * bfhi(v0[k].y) + e1 * bfhi(v1[k].y) + e2 * bfhi(v2[k].y));
            o.z = cvtpk(e0 * bflo(v0[k].z) + e1 * bflo(v1[k].z) + e2 * bflo(v2[k].z), e0 * bfhi(v0[k].z) + e1 * bfhi(v1[k].z) + e2 * bfhi(v2[k].z));
            o.w = cvtpk(e0 * bflo(v0[k].w) + e1 * bflo(v1[k].w) + e2 * bflo(v2[k].w), e0 * bfhi(v0[k].w) + e1 * bfhi(v1[k].w) + e2 * bfhi(v2[k].w));
            *(u32x4*)(o0 + off) = o; }
    }
}

template <class Epi> __device__ __forceinline__ void run_gemm(LAS unsigned char* lds, const bf16* A, const bf16* Bt, int N, int K, const Epi& E) {
    pg8::Gemm g{A, Bt, MROWS, N, K}; pg8::StaticOrder S; S.init(MROWS, N, (int)gridDim.x, (int)blockIdx.x);
    pg8::gemm_phase<Epi, pg8::StaticOrder, true, true>(lds, g, S, E);
}
#ifndef PHMASK
#define PHMASK 0xfff
#endif
#ifndef PROBE
#define PROBE -1
#endif
#define REP(n) for (int rep = 0; rep < 1; ++rep)
#if PROBE == 30
#define GSYNC() do { xcd_barrier(xbar); xcd_barrier(xbar); } while (0)
#else
#define GSYNC() xcd_barrier(xbar)
#endif
#define DUP(n, ...) do { if ((PROBE) == (n)) { __VA_ARGS__; } } while (0)
__global__ void __launch_bounds__(512) fwd_megakernel(Args a) {
    extern __shared__ __attribute__((aligned(16))) unsigned char lds_raw[];
    LAS unsigned char* lds = (LAS unsigned char*)lds_raw;
    cg::grid_group grid = cg::this_grid();
    unsigned char* ws = a.ws;
    float* ssq = (float*)(ws + WS_SSQ); const float* ropec = (const float*)(ws + WS_ROPE);
    bf16* xb = (bf16*)(ws + WS_XB); bf16* bufA = (bf16*)(ws + WS_A); bf16* bufB = (bf16*)(ws + WS_B);
    REP(0) { p0_prologue(a, lds); } DUP(0, p0_prologue(a, lds));
    if (threadIdx.x < 2) ((LAS unsigned*)(lds + LDS_BARST))[threadIdx.x] = 0u;
    grid.sync();
    const XcdBarrier xbar = xcd_barrier_post((unsigned*)(ws + WS_CTL) + CW_BAR, (volatile LAS unsigned*)(lds + LDS_BARST));
    REP(1) { run_gemm(lds, xb, (const bf16*)(ws + WS_WIN), NIN, DM, pg8::EpiQK{bufA, NIN, ssq, 4, 6, 8, a.in[10], a.in[11], ropec, ropec + SEQ * 8, (LAS float*)(lds + 131072)}); }
    GSYNC();
    REP(2) { p2_mixers(a, lds, 0); } DUP(2, p2_mixers(a, lds, 8));
    GSYNC();
    { run_gemm(lds, bufB, (const bf16*)(ws + WS_WO0), DM, DM, pg8::EpiResid{a.in[0], a.out, xb, ssq + MROWS}); }
    DUP(3, run_gemm(lds, bufB, (const bf16*)(ws + WS_WO0), DM, DM, pg8::EpiScale{bufA, DM, ssq}));
    GSYNC();
    REP(4) { run_gemm(lds, xb, (const bf16*)(ws + WS_WGU0), 2 * DFF, DM, pg8::EpiSwiGLU{bufA, ssq + MROWS}); } DUP(4, run_gemm(lds, xb, (const bf16*)(ws + WS_WGU0), 2 * DFF, DM, pg8::EpiSwiGLU{bufA, ssq + MROWS}));
    GSYNC();
    { run_gemm(lds, bufA, (const bf16*)(ws + WS_WDN0), DM, DFF, pg8::EpiResid{a.out, a.out, xb, ssq + 2 * MROWS}); }
    DUP(5, run_gemm(lds, bufA, (const bf16*)(ws + WS_WDN0), DM, DFF, pg8::EpiScale{bufB, DM, ssq}));
    GSYNC();
    REP(6) { run_gemm(lds, xb, (const bf16*)(ws + WS_WQKV), NQKV, DM, pg8::EpiQK{bufA, NQKV, ssq + 2 * MROWS, 0, 4, 8, a.in[20], a.in[21], ropec, ropec + SEQ * 8, (LAS float*)(lds + 131072)}); }
    GSYNC();
    REP(7) { p7_dilated(a, lds); } DUP(7, p7_dilated(a, lds));
    GSYNC();
    p7b_merge(a);
    GSYNC();
    { run_gemm(lds, bufB, (const bf16*)(ws + WS_WO1), DM, DM, pg8::EpiResid{a.out, a.out, xb, ssq + 3 * MROWS}); }
    GSYNC();
    REP(10) { run_gemm(lds, xb, (const bf16*)(ws + WS_WGU1), 2 * DFF, DM, pg8::EpiSwiGLU{bufA, ssq + 3 * MROWS}); }
    GSYNC();
    { run_gemm(lds, bufA, (const bf16*)(ws + WS_WDN1), DM, DFF, pg8::EpiResid{a.out, a.out, nullptr, nullptr}); }
}

extern "C" void kernel_launch(void* const* d_in, const int* in_sizes, int n_in, void* d_out, int out_size, void* d_ws, size_t ws_size, hipStream_t stream) {
    static int grid = 0;
    if (grid == 0) {
        if (n_in != 27 || out_size != MROWS * DM || ws_size < WS_END) { fprintf(stderr, "kernel_launch: unexpected shapes (n_in %d, out %d, ws %zu)\n", n_in, out_size, ws_size); grid = -1; return; }
        int dev = 0, cus = 0, per_cu = 0;
        hipGetDevice(&dev); hipDeviceGetAttribute(&cus, hipDeviceAttributeMultiprocessorCount, dev);
        if (hipFuncSetAttribute((const void*)fwd_megakernel, hipFuncAttributeMaxDynamicSharedMemorySize, LDS_BYTES) != hipSuccess) { fprintf(stderr, "kernel_launch: hipFuncSetAttribute failed\n"); grid = -1; return; }
        if (hipOccupancyMaxActiveBlocksPerMultiprocessor(&per_cu, (const void*)fwd_megakernel, 512, LDS_BYTES) != hipSuccess || per_cu < 1) { fprintf(stderr, "kernel_launch: occupancy query failed (%d)\n", per_cu); (void)hipGetLastError(); per_cu = 1; }
        grid = cus * (per_cu > 1 ? 1 : per_cu);
        fprintf(stderr, "kernel_launch: grid %d (cus %d, per_cu %d)\n", grid, cus, per_cu);
    }
    if (grid < 0) return;
    Args a{};
    for (int i = 0; i < 27; ++i) a.in[i] = (const float*)d_in[i];
    a.out = (float*)d_out; a.ws = (unsigned char*)d_ws;
    void* args[] = {&a};
    hipError_t e = hipLaunchCooperativeKernel((const void*)fwd_megakernel, dim3(grid), dim3(512), args, LDS_BYTES, stream);
    if (e != hipSuccess) fprintf(stderr, "kernel_launch: cooperative launch failed: %s (grid %d)\n", hipGetErrorString(e), grid);
}
```
